# Optimizing an MI355X kernel written in HIP

```python
import jax, jax.numpy as jnp
from jax import lax
import numpy as np

D_MODEL = 1024
BATCH = 16
SEQ = 2048
DEPTH = 2

N_A_LAYERS = DEPTH // 2
N_B_LAYERS = DEPTH - N_A_LAYERS

A_HEADS = 16
A_HEAD_DIM = D_MODEL // A_HEADS
DILATED_PATTERNS = ((128, 1), (512, 4), (2048, 16))
BAND = max(w // d for w, d in DILATED_PATTERNS)

B_HEADS = 16
B_NOPE_DIM = 64
B_ROPE_DIM = 32
B_V_DIM = 64
Q_RANK = 384
KV_RANK = 256
ROPE_BASE = 10000.0
Q_BLOCK = 128

D_FF = 2816
CONV_WIDTH = 3

ALPHA = (2.0 * DEPTH) ** 0.25
BETA = (8.0 * DEPTH) ** -0.25
LN_EPS = 1e-5
RMS_EPS = 1e-6

kernel_name = 'yoco_dilated_mla_convffn_deepnorm'


def layer_norm(x, g, b):
    xf = x.astype(jnp.float32)
    mu = jnp.mean(xf, axis=-1, keepdims=True)
    var = jnp.mean(jnp.square(xf - mu), axis=-1, keepdims=True)
    return ((xf - mu) * lax.rsqrt(var + LN_EPS) * g.astype(jnp.float32) + b.astype(jnp.float32)).astype(x.dtype)


def rms_norm(x, g):
    xf = x.astype(jnp.float32)
    ms = jnp.mean(jnp.square(xf), axis=-1, keepdims=True)
    return (xf * lax.rsqrt(ms + RMS_EPS) * g.astype(jnp.float32)).astype(x.dtype)


def alibi_slopes(n_heads):
    return jnp.asarray([2.0 ** (-8.0 * (h + 1) / n_heads) for h in range(n_heads)], dtype=jnp.float32)


def rope_tables(seq):
    inv_freq = ROPE_BASE ** (-jnp.arange(0, B_ROPE_DIM, 2, dtype=jnp.float32) / B_ROPE_DIM)
    ang = jnp.arange(seq, dtype=jnp.float32)[:, None] * inv_freq[None, :]
    return jnp.cos(ang), jnp.sin(ang)


def apply_rope(t, cos, sin):
    tf = t.astype(jnp.float32)
    t1, t2 = jnp.split(tf, 2, axis=-1)
    return jnp.concatenate([t1 * cos - t2 * sin, t2 * cos + t1 * sin], axis=-1).astype(t.dtype)


def dilated_branch(q, k, v, window, dilation, slopes):
    bsz, seq, heads, dh = q.shape
    sub_len = seq // dilation
    n_blk = -(-sub_len // BAND)
    sub_pad = n_blk * BAND
    steps = window // dilation

    def to_sub(t):
        t = t.reshape(bsz, sub_len, dilation, heads, dh)
        return jnp.pad(t, ((0, 0), (0, sub_pad - sub_len), (0, 0), (0, 0), (0, 0)))

    def band(t):
        t = jnp.pad(t, ((0, 0), (BAND, 0), (0, 0), (0, 0), (0, 0)))
        t = t.reshape(bsz, n_blk + 1, BAND, dilation, heads, dh)
        return jnp.concatenate([t[:, :-1], t[:, 1:]], axis=2)

    qb = to_sub(q).reshape(bsz, n_blk, BAND, dilation, heads, dh)
    kb = band(to_sub(k))
    vb = band(to_sub(v))

    s = jnp.einsum('bnqrhd,bnkrhd->bnrhqk', qb, kb).astype(jnp.float32) * (dh ** -0.5)
    qi = jnp.arange(BAND)[:, None]
    ki = jnp.arange(2 * BAND)[None, :]
    back = BAND + qi - ki
    kpos = jnp.arange(n_blk)[:, None, None] * BAND - BAND + ki[None]
    valid = (back >= 0) & (back <= steps) & (kpos >= 0)
    bias = -slopes[:, None, None] * (dilation * back).astype(jnp.float32)[None]
    s = jnp.where(valid[:, None, None], s + bias, -jnp.inf)
    m = jnp.max(s, axis=-1, keepdims=True)
    p = jnp.exp(s - m)
    den = jnp.sum(p, axis=-1)
    lse = m[..., 0] + jnp.log(den)
    o = jnp.einsum('bnrhqk,bnkrhd->bnqrhd', p.astype(vb.dtype), vb).astype(jnp.float32)
    den_t = jnp.transpose(den, (0, 1, 4, 2, 3))
    o = o / den_t[..., None]
    o = o.reshape(bsz, sub_pad, dilation, heads, dh)[:, :sub_len].reshape(bsz, seq, heads, dh)
    lse = jnp.transpose(lse, (0, 1, 4, 2, 3)).reshape(bsz, sub_pad, dilation, heads)[:, :sub_len]
    return o, lse.reshape(bsz, seq, heads)


def dilated_mixer(x, w_qkv, w_o):
    bsz, seq, _ = x.shape
    qkv = (x @ w_qkv).reshape(bsz, seq, 3, A_HEADS, A_HEAD_DIM)
    q, k, v = qkv[:, :, 0], qkv[:, :, 1], qkv[:, :, 2]
    slopes = alibi_slopes(A_HEADS)
    outs, lses = [], []
    for window, dilation in DILATED_PATTERNS:
        o, l = dilated_branch(q, k, v, window, dilation, slopes)
        outs.append(o)
        lses.append(l)
    wts = jax.nn.softmax(jnp.stack(lses, axis=0), axis=0)
    o = jnp.einsum('pbsh,pbshd->bshd', wts, jnp.stack(outs, axis=0))
    return o.astype(x.dtype).reshape(bsz, seq, A_HEADS * A_HEAD_DIM) @ w_o


def shared_latent_kv(x, w_dkv, kv_norm_g, w_kr, w_uk, w_uv, cos, sin):
    bsz, seq, _ = x.shape
    c_kv = rms_norm(x @ w_dkv, kv_norm_g)
    k_nope = (c_kv @ w_uk).reshape(bsz, seq, B_HEADS, B_NOPE_DIM)
    v = (c_kv @ w_uv).reshape(bsz, seq, B_HEADS, B_V_DIM)
    k_rope = apply_rope(x @ w_kr, cos[None], sin[None])
    return k_nope, k_rope, v


def mla_mixer(x, w_dq, q_norm_g, w_uq, w_o, k_nope, k_rope, v, cos, sin):
    bsz, seq, _ = x.shape
    q = (rms_norm(x @ w_dq, q_norm_g) @ w_uq).reshape(bsz, seq, B_HEADS, B_NOPE_DIM + B_ROPE_DIM)
    q_nope = q[..., :B_NOPE_DIM]
    q_rope = apply_rope(q[..., B_NOPE_DIM:], cos[None, :, None], sin[None, :, None])
    n_q = seq // Q_BLOCK
    qn_blocks = q_nope.reshape(bsz, n_q, Q_BLOCK, B_HEADS, B_NOPE_DIM).transpose(1, 0, 2, 3, 4)
    qr_blocks = q_rope.reshape(bsz, n_q, Q_BLOCK, B_HEADS, B_ROPE_DIM).transpose(1, 0, 2, 3, 4)
    kpos = jnp.arange(seq)
    scale = (B_NOPE_DIM + B_ROPE_DIM) ** -0.5

    def attend(args):
        qn, qr, blk = args
        s = (jnp.einsum('bqhd,bkhd->bhqk', qn, k_nope)
             + jnp.einsum('bqhr,bkr->bhqk', qr, k_rope)).astype(jnp.float32) * scale
        qpos = blk * Q_BLOCK + jnp.arange(Q_BLOCK)
        s = jnp.where(kpos[None, :] <= qpos[:, None], s, -jnp.inf)
        p = jax.nn.softmax(s, axis=-1)
        return jnp.einsum('bhqk,bkhd->bqhd', p.astype(v.dtype), v)

    o = lax.map(attend, (qn_blocks, qr_blocks, jnp.arange(n_q)))
    o = o.transpose(1, 0, 2, 3, 4).reshape(bsz, seq, B_HEADS * B_V_DIM)
    return o @ w_o


def conv_ffn(x, w_in, conv_w, conv_b, w_out):
    seq = x.shape[1]
    u = x @ w_in
    up = jnp.pad(u, ((0, 0), (CONV_WIDTH - 1, 0), (0, 0)))
    c = conv_b
    for j in range(CONV_WIDTH):
        c = c + conv_w[j] * up[:, j:j + seq]
    gate, val = jnp.split(c, 2, axis=-1)
    return (jax.nn.silu(gate) * val) @ w_out


def setup_inputs(seed: int = 0) -> dict:
    key = jax.random.key(seed)
    ks = iter(jax.random.split(key, 32))

    def dense(shape, fan_in, scale=1.0):
        return jax.random.normal(next(ks), shape, jnp.float32) * (scale * fan_in ** -0.5)

    def gain(shape):
        return 1.0 + 0.02 * jax.random.normal(next(ks), shape, jnp.float32)

    def bias(shape):
        return 0.02 * jax.random.normal(next(ks), shape, jnp.float32)

    hd_a = A_HEADS * A_HEAD_DIM
    v_scale = jnp.concatenate([jnp.ones((2 * hd_a,), jnp.float32), jnp.full((hd_a,), BETA, jnp.float32)])
    return {
        'x': jax.random.normal(next(ks), (BATCH, SEQ, D_MODEL), jnp.float32),
        'a_w_qkv': dense((N_A_LAYERS, D_MODEL, 3 * hd_a), D_MODEL) * v_scale,
        'a_w_o': dense((N_A_LAYERS, hd_a, D_MODEL), hd_a, BETA),
        'kv_w_dkv': dense((D_MODEL, KV_RANK), D_MODEL),
        'kv_norm_g': gain((KV_RANK,)),
        'kv_w_kr': dense((D_MODEL, B_ROPE_DIM), D_MODEL),
        'kv_w_uk': dense((KV_RANK, B_HEADS * B_NOPE_DIM), KV_RANK),
        'kv_w_uv': dense((KV_RANK, B_HEADS * B_V_DIM), KV_RANK, BETA),
        'b_w_dq': dense((N_B_LAYERS, D_MODEL, Q_RANK), D_MODEL),
        'b_q_norm_g': gain((N_B_LAYERS, Q_RANK)),
        'b_w_uq': dense((N_B_LAYERS, Q_RANK, B_HEADS * (B_NOPE_DIM + B_ROPE_DIM)), Q_RANK),
        'b_w_o': dense((N_B_LAYERS, B_HEADS * B_V_DIM, D_MODEL), B_HEADS * B_V_DIM, BETA),
        'ffn_w_in': dense((DEPTH, D_MODEL, 2 * D_FF), D_MODEL),
        'ffn_conv_w': dense((DEPTH, CONV_WIDTH, 2 * D_FF), CONV_WIDTH),
        'ffn_conv_b': bias((DEPTH, 2 * D_FF)),
        'ffn_w_out': dense((DEPTH, D_FF, D_MODEL), D_FF, BETA),
        'ln_mix_g': gain((DEPTH, D_MODEL)),
        'ln_mix_b': bias((DEPTH, D_MODEL)),
        'ln_ffn_g': gain((DEPTH, D_MODEL)),
        'ln_ffn_b': bias((DEPTH, D_MODEL)),
    }


def reference(x, a_w_qkv, a_w_o, kv_w_dkv, kv_norm_g, kv_w_kr, kv_w_uk, kv_w_uv,
              b_w_dq, b_q_norm_g, b_w_uq, b_w_o, ffn_w_in, ffn_conv_w, ffn_conv_b, ffn_w_out,
              ln_mix_g, ln_mix_b, ln_ffn_g, ln_ffn_b):
    cos, sin = rope_tables(x.shape[1])
    k_nope = k_rope = v_shared = None
    for layer in range(DEPTH):
        if layer == N_A_LAYERS:
            k_nope, k_rope, v_shared = shared_latent_kv(x, kv_w_dkv, kv_norm_g, kv_w_kr,
                                                        kv_w_uk, kv_w_uv, cos, sin)
        if layer < N_A_LAYERS:
            mix = dilated_mixer(x, a_w_qkv[layer], a_w_o[layer])
        else:
            j = layer - N_A_LAYERS
            mix = mla_mixer(x, b_w_dq[j], b_q_norm_g[j], b_w_uq[j], b_w_o[j],
                            k_nope, k_rope, v_shared, cos, sin)
        x = layer_norm(ALPHA * x + mix, ln_mix_g[layer], ln_mix_b[layer])
        f = conv_ffn(x, ffn_w_in[layer], ffn_conv_w[layer], ffn_conv_b[layer], ffn_w_out[layer])
        x = layer_norm(ALPHA * x + f, ln_ffn_g[layer], ln_ffn_b[layer])
    return x
```

```cpp
#include <hip/hip_runtime.h>
#include <hip/hip_cooperative_groups.h>
#include <cstdio>
#include <cstdint>
#include <cmath>
namespace cg = cooperative_groups;
namespace pg8 {
#define PG8_LAS __attribute__((address_space(3)))
typedef unsigned short bf16_t;
typedef short bf16x8 __attribute__((ext_vector_type(8)));
typedef float f32x4 __attribute__((ext_vector_type(4)));
typedef unsigned u32x4 __attribute__((ext_vector_type(4)));
constexpr int BM = 256, BK = 64, HALF = 128, HTB = HALF * BK * 2  , STAGE_BYTES = 8 * HTB, NXCD = 8, WGM = 8;

__host__ __device__ __forceinline__ int lds_byte(int r, int c) { const int st = (r >> 4) * 2 + (c >> 5), rr = r & 15, cc = c & 31, ob = rr * 64 + cc * 2; return st * 1024 + (ob ^ (((ob >> 9) & 1) << 5)); }
__host__ __device__ __forceinline__ void stage_rc(int b, int& R, int& C) { const int st = b / 1024, sb = b % 1024, swz = sb ^ (((sb >> 9) & 1) << 5); R = (st >> 1) * 16 + swz / 64; C = (st & 1) * 32 + (swz % 64) / 2; }
__host__ __device__ __forceinline__ int perm32(int rho) { const int n = rho >> 4, i = rho & 15; return 8 * (i >> 2) + 4 * n + (i & 3); }

__device__ __forceinline__ int pg8_ltid() { int t = threadIdx.x; asm volatile("" : "+v"(t)); return t; }
struct Unit { int pm, pn; };
struct Gemm { const bf16_t* A; const bf16_t* Bt; int M, N, K, lda, ldb; };

struct StaticOrder {
    int nM, nN, nwg, G, c;
    __host__ __device__ void init(int M, int N, int G_, int c_) { nM = M / BM; nN = N / BM; nwg = nM * nN; G = G_; c = c_; }
    __host__ __device__ bool next(int i, Unit& u) const {
        const long L = (long)i * G + c; if (L >= nwg) return false;
        int wgid = (int)L; { const int q = nwg / NXCD, r = nwg % NXCD, xcd = wgid % NXCD, off = wgid / NXCD; wgid = (xcd < r ? xcd * (q + 1) : r * (q + 1) + (xcd - r) * q) + off; }
        const int nig = WGM * nN, gid = wgid / nig, fm = gid * WGM, gsz = (nM - fm) < WGM ? (nM - fm) : WGM;
        u.pm = fm + ((wgid % nig) % gsz); u.pn = (wgid % nig) / gsz; return true;
    }
    __device__ __forceinline__ void a_ready(const Unit&) const {}
    __device__ __forceinline__ void done(const Unit&) const {}
};

__device__ __forceinline__ unsigned cvt_pk_bf16(float lo, float hi) { unsigned r; asm volatile("v_cvt_pk_bf16_f32 %0, %1, %2" : "=v"(r) : "v"(lo), "v"(hi)); return r; }
typedef float f32x2 __attribute__((ext_vector_type(2)));
__device__ __forceinline__ f32x2 gelu_pk(f32x2 v) {
    const f32x2 av = __builtin_elementwise_abs(v), d = av * 0.2316418882f + 1.0f;
    f32x2 t; t.x = __builtin_amdgcn_rcpf(d.x); t.y = __builtin_amdgcn_rcpf(d.y);
    f32x2 q = t * 0.5307027145f + (-0.7265760135f); q = q * t + 0.7107068705f; q = q * t + (-0.142248368f); q = q * t + 0.127414796f; q = q * t;
    const f32x2 s = (v * v) * (-0.72134752044f);
    f32x2 e; e.x = __builtin_amdgcn_exp2f(s.x); e.y = __builtin_amdgcn_exp2f(s.y);
    const f32x2 m = v * (q * e), r = v - m;
    f32x2 o; o.x = v.x < 0.f ? m.x : r.x; o.y = v.y < 0.f ? m.y : r.y; return o;
}

template <int ACT  > struct EpiBf16 {
    static constexpr bool PERM = true, AFTER_DRAIN = false; static_assert(ACT == 0 || ACT == 1, "EpiBf16: ACT is 0 (none) or 1 (gelu_pk)");
    bf16_t* O; int ldc; const float* bias; int split_cols; size_t split_stride; float scale0;
    __device__ __forceinline__ void operator()(const f32x4 (&acc)[2][2][4][2], const Unit& u, int wr, int wc, int fr, int fq) const {
        const int row0 = u.pm * BM + wr * 64 + fr; int colt = u.pn * BM; bf16_t* base = O;
        float sc = 1.f; if (split_cols) { const int t = colt / split_cols; base += (size_t)t * split_stride; colt -= t * split_cols; if (t == 0) sc = scale0; }
        const int col0 = colt + wc * 32 + 8 * fq, bcol0 = u.pn * BM + wc * 32 + 8 * fq;
        f32x4 bv[2][2];
#pragma unroll
        for (int bj = 0; bj < 2; ++bj)
#pragma unroll
            for (int n = 0; n < 2; ++n) bv[bj][n] = bias ? *(const f32x4*)(bias + bcol0 + bj * HALF + 4 * n) : (f32x4){0.f, 0.f, 0.f, 0.f};
#pragma unroll
        for (int ai = 0; ai < 2; ++ai)
#pragma unroll
            for (int m = 0; m < 4; ++m) { bf16_t* rowp = base + (size_t)(row0 + ai * HALF + m * 16) * ldc + col0;
#pragma unroll
                for (int bj = 0; bj < 2; ++bj) { f32x4 v0 = acc[ai][bj][m][0] + bv[bj][0], v1 = acc[ai][bj][m][1] + bv[bj][1];
                    if (ACT == 1) { f32x2 a = gelu_pk((f32x2){v0[0], v0[1]}), b = gelu_pk((f32x2){v0[2], v0[3]}), c = gelu_pk((f32x2){v1[0], v1[1]}), d = gelu_pk((f32x2){v1[2], v1[3]});
                        v0 = (f32x4){a.x, a.y, b.x, b.y}; v1 = (f32x4){c.x, c.y, d.x, d.y}; }
                    v0 = v0 * sc; v1 = v1 * sc; u32x4 w; w.x = cvt_pk_bf16(v0[0], v0[1]); w.y = cvt_pk_bf16(v0[2], v0[3]); w.z = cvt_pk_bf16(v1[0], v1[1]); w.w = cvt_pk_bf16(v1[2], v1[3]);
                    *(u32x4*)(rowp + bj * HALF) = w; } }
    }
};
typedef unsigned u32x2 __attribute__((ext_vector_type(2)));
struct EpiMla {
    static constexpr bool PERM = true, AFTER_DRAIN = false;
    bf16_t* O; int ldc; int split_cols; size_t split_stride; const float* rs; int rsi; float cscale; const float* rope; int qmode; float invk;
    __device__ __forceinline__ void operator()(const f32x4 (&acc)[2][2][4][2], const Unit& u, int wr, int wc, int fr, int fq) const {
        const int row0 = u.pm * BM + wr * 64 + fr; int colt = u.pn * BM; bf16_t* base = O;
        if (split_cols) { const int t = colt / split_cols; base += (size_t)t * split_stride; colt -= t * split_cols; }
        const int col0 = colt + wc * 32 + 8 * fq;
#pragma unroll
        for (int ai = 0; ai < 2; ++ai)
#pragma unroll
            for (int m = 0; m < 4; ++m) { const int row = row0 + ai * HALF + m * 16; const float s = __builtin_amdgcn_rsqf(rs[row * 2 + rsi] * invk + 1e-6f) * cscale; const int bb_ = row >> 11, tok_ = row & 2047;
#pragma unroll
                for (int bj = 0; bj < 2; ++bj) { f32x4 v0 = acc[ai][bj][m][0] * s, v1 = acc[ai][bj][m][1] * s;
                    if (qmode) { const int o = (col0 + bj * HALF) % 96;
                        if (o >= 64) { const int i0 = (o - 64) >> 1; const int t = row & 2047; const f32x4* tb = (const f32x4*)(rope + ((size_t)t * 16 + i0) * 2); const f32x4 c0 = tb[0], c1 = tb[1];
                            float a, b;
                            a = v0[0]; b = v0[1]; v0[0] = a * c0[0] - b * c0[1]; v0[1] = b * c0[0] + a * c0[1];
                            a = v0[2]; b = v0[3]; v0[2] = a * c0[2] - b * c0[3]; v0[3] = b * c0[2] + a * c0[3];
                            a = v1[0]; b = v1[1]; v1[0] = a * c1[0] - b * c1[1]; v1[1] = b * c1[0] + a * c1[1];
                            a = v1[2]; b = v1[3]; v1[2] = a * c1[2] - b * c1[3]; v1[3] = b * c1[2] + a * c1[3]; } }
                    u32x4 w; w.x = cvt_pk_bf16(v0[0], v0[1]); w.y = cvt_pk_bf16(v0[2], v0[3]); w.z = cvt_pk_bf16(v1[0], v1[1]); w.w = cvt_pk_bf16(v1[2], v1[3]);
                    { const int col = col0 + bj * HALF; const int hh_ = col / ldc, dd_ = col - hh_ * ldc; *(u32x4*)(base + ((size_t)(bb_ * 16 + hh_) * 2048 + tok_) * ldc + dd_) = w; } } }
    }
};
struct EpiQKV {
    static constexpr bool PERM = true, AFTER_DRAIN = false;
    bf16_t* O; size_t t_stride; float scale0;
    __device__ __forceinline__ void operator()(const f32x4 (&acc)[2][2][4][2], const Unit& u, int wr, int wc, int fr, int fq) const {
        const int row0 = u.pm * BM + wr * 64 + fr; const int colt = u.pn * BM; const int t = colt >> 10; bf16_t* base = O + (size_t)t * t_stride; const float sc = t == 0 ? scale0 : 1.f;
        const int cc0 = (colt & 1023) + wc * 32 + 8 * fq;
#pragma unroll
        for (int ai = 0; ai < 2; ++ai)
#pragma unroll
            for (int m = 0; m < 4; ++m) { const int row = row0 + ai * HALF + m * 16; const int bb_ = row >> 11, tok_ = row & 2047;
#pragma unroll
                for (int bj = 0; bj < 2; ++bj) { const int cc = cc0 + bj * HALF; const int hh_ = cc >> 6, dd_ = cc & 63;
                    const f32x4 v0 = acc[ai][bj][m][0] * sc, v1 = acc[ai][bj][m][1] * sc;
                    u32x4 w; w.x = cvt_pk_bf16(v0[0], v0[1]); w.y = cvt_pk_bf16(v0[2], v0[3]); w.z = cvt_pk_bf16(v1[0], v1[1]); w.w = cvt_pk_bf16(v1[2], v1[3]);
                    *(u32x4*)(base + ((size_t)(bb_ * 16 + hh_) * 2048 + tok_) * 64 + dd_) = w; } }
    }
};
struct EpiLat {
    static constexpr bool PERM = true, AFTER_DRAIN = false;
    bf16_t* O; float* ss; const float* rope; bf16_t* KR;
    __device__ __forceinline__ void operator()(const f32x4 (&acc)[2][2][4][2], const Unit& u, int wr, int wc, int fr, int fq) const {
        const int row0 = u.pm * BM + wr * 64 + fr; const int col0 = u.pn * BM + wc * 32 + 8 * fq;
#pragma unroll
        for (int ai = 0; ai < 2; ++ai)
#pragma unroll
            for (int m = 0; m < 4; ++m) { const int row = row0 + ai * HALF + m * 16; bf16_t* rowp = O + (size_t)row * 768 + col0; float sq = 0.f;
#pragma unroll
                for (int bj = 0; bj < 2; ++bj) { const f32x4 v0 = acc[ai][bj][m][0], v1 = acc[ai][bj][m][1];
                    u32x4 w; w.x = cvt_pk_bf16(v0[0], v0[1]); w.y = cvt_pk_bf16(v0[2], v0[3]); w.z = cvt_pk_bf16(v1[0], v1[1]); w.w = cvt_pk_bf16(v1[2], v1[3]);
                    *(u32x4*)(rowp + bj * HALF) = w;
                    if (u.pn < 2 || bj == 0) sq += (v0[0] * v0[0] + v0[1] * v0[1]) + (v0[2] * v0[2] + v0[3] * v0[3]) + (v1[0] * v1[0] + v1[1] * v1[1]) + (v1[2] * v1[2] + v1[3] * v1[3]);
                    else if (wc == 0) {
                        const int t = row & 2047; const f32x4* tb = (const f32x4*)(rope + ((size_t)t * 16 + 4 * fq) * 2); const f32x4 c0 = tb[0], c1 = tb[1];
                        u32x4 k; k.x = cvt_pk_bf16(v0[0] * c0[0] - v0[1] * c0[1], v0[1] * c0[0] + v0[0] * c0[1]); k.y = cvt_pk_bf16(v0[2] * c0[2] - v0[3] * c0[3], v0[3] * c0[2] + v0[2] * c0[3]);
                        k.z = cvt_pk_bf16(v1[0] * c1[0] - v1[1] * c1[1], v1[1] * c1[0] + v1[0] * c1[1]); k.w = cvt_pk_bf16(v1[2] * c1[2] - v1[3] * c1[3], v1[3] * c1[2] + v1[2] * c1[3]);
                        *(u32x4*)(KR + (size_t)row * 32 + 8 * fq) = k; } }
                sq += __shfl_xor(sq, 16); sq += __shfl_xor(sq, 32);
                if (fq == 0) atomicAdd(ss + row * 2 + (u.pn == 0 ? 0 : 1), sq); }
    }
};
struct EpiFfn1 {
    static constexpr bool PERM = true, AFTER_DRAIN = false;
    bf16_t* H; bf16_t* UE; const float* cw; const float* cb;
    __device__ __forceinline__ void operator()(const f32x4 (&acc)[2][2][4][2], const Unit& u, int wr, int wc, int fr, int fq) const {
        const int f0 = u.pn * 128 + wc * 32 + 8 * fq;
#pragma unroll
        for (int n = 0; n < 2; ++n) {
            const int f = f0 + 4 * n;
            f32x4 w[2][3], bb[2];
#pragma unroll
            for (int bj = 0; bj < 2; ++bj) {
#pragma unroll
                for (int j = 0; j < 3; ++j) w[bj][j] = *(const f32x4*)(cw + j * 5632 + bj * 2816 + f);
                bb[bj] = *(const f32x4*)(cb + bj * 2816 + f); }
#pragma unroll
            for (int ai = 0; ai < 2; ++ai) {
                const int blk = 4 * u.pm + 2 * ai + wr;
#pragma unroll
                for (int m = 0; m < 4; ++m) {
                    f32x4 c[2];
#pragma unroll
                    for (int bj = 0; bj < 2; ++bj) {
                        const f32x4 X = acc[ai][bj][m][n]; f32x4 p1, p2;
#pragma unroll
                        for (int e = 0; e < 4; ++e) {
                            const float xe = X[e]; const int xi = __builtin_bit_cast(int, xe);
                            int b1 = 0, b2 = 0;
                            if (m > 0) { const float pe = acc[ai][bj][m > 0 ? m - 1 : 0][n][e]; const int pi = __builtin_bit_cast(int, pe);
                                b1 = __builtin_amdgcn_update_dpp(0, pi, 0x10F, 0xf, 0xf, true); b2 = __builtin_amdgcn_update_dpp(0, pi, 0x10E, 0xf, 0xf, true); }
                            p1[e] = __builtin_bit_cast(float, __builtin_amdgcn_update_dpp(b1, xi, 0x111, 0xf, 0xf, false));
                            p2[e] = __builtin_bit_cast(float, __builtin_amdgcn_update_dpp(b2, xi, 0x112, 0xf, 0xf, false)); }
                        c[bj] = bb[bj] + w[bj][2] * X + w[bj][1] * p1 + w[bj][0] * p2;
                        if (m == 0 && fr < 2) { u32x2 t; t.x = cvt_pk_bf16(X[0], X[1]); t.y = cvt_pk_bf16(X[2], X[3]); *(u32x2*)(UE + ((size_t)(blk * 4 + fr) * 2 + bj) * 2816 + f) = t; }
                        if (m == 3 && fr >= 14) { u32x2 t; t.x = cvt_pk_bf16(X[0], X[1]); t.y = cvt_pk_bf16(X[2], X[3]); *(u32x2*)(UE + ((size_t)(blk * 4 + 2 + (fr - 14)) * 2 + bj) * 2816 + f) = t; }
                    }
                    f32x4 hv;
#pragma unroll
                    for (int e = 0; e < 4; ++e) { const float g = c[0][e]; hv[e] = g * __builtin_amdgcn_rcpf(1.0f + __expf(-g)) * c[1][e]; }
                    const int row = u.pm * BM + ai * HALF + wr * 64 + m * 16 + fr;
                    u32x2 t; t.x = cvt_pk_bf16(hv[0], hv[1]); t.y = cvt_pk_bf16(hv[2], hv[3]);
                    *(u32x2*)(H + (size_t)row * 2816 + f) = t;
                }
            }
        }
    }
};
template <class Epi, class Sched, bool ALIGN_EPI = false, bool SP2 = false>
__device__ __forceinline__ void gemm_phase(PG8_LAS unsigned char* lds, const Gemm g, const Sched& S, const Epi& E) {
    const int tid = pg8_ltid(), wid = __builtin_amdgcn_readfirstlane(tid >> 6), lane = tid & 63, wr = wid >> 2, wc = wid & 3, fr = lane & 15, fq = lane >> 4;
    const int K = g.K, nt = K / BK;
    unsigned voffA[2], voffB[2];
#pragma unroll
    for (int i = 0; i < 2; ++i) { int R, C; stage_rc(tid * 16 + i * 8192, R, C); const int Rb = Epi::PERM ? ((R & ~31) + perm32(R & 31)) : R;
        voffA[i] = (unsigned)(R * g.lda + C) * 2u; voffB[i] = (unsigned)(Rb * g.ldb + C) * 2u; }
    const size_t kstep = (size_t)(BK * 2);
    const size_t hstepA = (size_t)HALF * g.lda * 2, hstepB = (size_t)HALF * g.ldb * 2;
    const size_t tstepA = 2 * hstepA, tstepB = 2 * hstepB;
    const unsigned ldsw = (unsigned)wid * 1024u;
    const int aoff = lds_byte(wr * 64 + fr, fq * 8), boff = lds_byte(wc * 32 + fr, fq * 8);
#define PG8_SA(b, h) (((b) * 2 + (h)) * HTB)
#define PG8_SB(b, h) ((4 + (b) * 2 + (h)) * HTB)
#define PG8_STAGE(bufoff, gbase, voff) do { _Pragma("unroll") for (int _i = 0; _i < 2; ++_i) \
        __builtin_amdgcn_global_load_lds((const unsigned*)((const char*)(gbase) + (voff)[_i]), (PG8_LAS unsigned*)(lds + (bufoff) + ldsw + _i * 8192), 16, 0, 0); } while (0)
#define PG8_LDA(dst, b, h) do { _Pragma("unroll") for (int m = 0; m < 4; ++m) _Pragma("unroll") for (int k = 0; k < 2; ++k) dst[m][k] = *(const PG8_LAS bf16x8*)(lds + PG8_SA(b, h) + aoff + m * 2048 + k * 1024); } while (0)
#define PG8_LDB(dst, b, h) do { _Pragma("unroll") for (int n = 0; n < 2; ++n) _Pragma("unroll") for (int k = 0; k < 2; ++k) dst[n][k] = *(const PG8_LAS bf16x8*)(lds + PG8_SB(b, h) + boff + n * 2048 + k * 1024); } while (0)
#define PG8_MMA(ai, bj, At, Bt) do { __builtin_amdgcn_s_setprio(1); _Pragma("unroll") for (int m = 0; m < 4; ++m) _Pragma("unroll") for (int n = 0; n < 2; ++n) _Pragma("unroll") for (int k = 0; k < 2; ++k) \
        acc[ai][bj][m][n] = __builtin_amdgcn_mfma_f32_16x16x32_bf16(Bt[n][k], At[m][k], acc[ai][bj][m][n], 0, 0, 0); __builtin_amdgcn_s_setprio(0); } while (0)
#define PG8_WAIT_V(n) asm volatile("s_waitcnt vmcnt(" #n ")" ::: "memory")
#define PG8_WAIT_L(n) asm volatile("s_waitcnt lgkmcnt(" #n ")" ::: "memory")
#define PG8_BAR __builtin_amdgcn_s_barrier()
#define PG8_SCHED __builtin_amdgcn_sched_barrier(0)
    Unit cur, nxt; int ui = 0;
    if (!S.next(0, cur)) return;
    f32x4 acc[2][2][4][2];
#pragma unroll
    for (int a = 0; a < 2; ++a)
#pragma unroll
        for (int b = 0; b < 2; ++b)
#pragma unroll
            for (int m = 0; m < 4; ++m)
#pragma unroll
                for (int n = 0; n < 2; ++n) acc[a][b][m][n] = (f32x4){0.f, 0.f, 0.f, 0.f};
    bf16x8 At[4][2], B0[2][2], B1[2][2];
    const char* cA = (const char*)g.A + (size_t)cur.pm * tstepA; const char* cB = (const char*)g.Bt + (size_t)cur.pn * tstepB;
    S.a_ready(cur);
    if constexpr (SP2) {
        PG8_STAGE(PG8_SB(0, 0), cB, voffB); PG8_STAGE(PG8_SB(0, 1), cB + hstepB, voffB); PG8_STAGE(PG8_SA(0, 0), cA, voffA); PG8_STAGE(PG8_SA(0, 1), cA + hstepA, voffA);
        if (wr == 1) PG8_BAR;
        PG8_WAIT_V(2); PG8_BAR;
        PG8_STAGE(PG8_SB(1, 0), cB + kstep, voffB); PG8_STAGE(PG8_SA(1, 0), cA + kstep, voffA); PG8_STAGE(PG8_SB(1, 1), cB + hstepB + kstep, voffB);
        PG8_WAIT_V(6); PG8_BAR;
    } else {
        PG8_STAGE(PG8_SB(0, 0), cB, voffB); PG8_STAGE(PG8_SA(0, 0), cA, voffA); PG8_STAGE(PG8_SB(0, 1), cB + hstepB, voffB); PG8_STAGE(PG8_SA(0, 1), cA + hstepA, voffA);
        if (wr == 1) PG8_BAR;
        PG8_WAIT_V(4); PG8_BAR;
        PG8_STAGE(PG8_SB(1, 0), cB + kstep, voffB); PG8_STAGE(PG8_SA(1, 0), cA + kstep, voffA); PG8_STAGE(PG8_SB(1, 1), cB + hstepB + kstep, voffB);
        PG8_WAIT_V(6); PG8_BAR;
    }
    for (;;) {
        const bool has_next = S.next(ui + 1, nxt);
        const char* nA = has_next ? (const char*)g.A + (size_t)nxt.pm * tstepA : cA; const char* nB = has_next ? (const char*)g.Bt + (size_t)nxt.pn * tstepB : cB;
        for (int t = 0; t < nt; t += 2) {
            const bool last = (t == nt - 2);
            const char* a1 = cA + (size_t)(t + 1) * kstep;
            const char* a2 = last ? nA : cA + (size_t)(t + 2) * kstep; const char* b2 = last ? nB : cB + (size_t)(t + 2) * kstep;
            const char* a3 = a2 + kstep; const char* b3 = b2 + kstep;
            if (last && has_next) S.a_ready(nxt);
            if constexpr (SP2) {
            PG8_LDB(B0, 0, 0); PG8_LDB(B1, 0, 1); PG8_SCHED; PG8_LDA(At, 0, 0); PG8_STAGE(PG8_SA(1, 1), a1 + hstepA, voffA);
            PG8_WAIT_V(8); PG8_WAIT_L(0); PG8_BAR; PG8_MMA(0, 0, At, B0); PG8_MMA(0, 1, At, B1); PG8_BAR; PG8_SCHED;
            PG8_LDA(At, 0, 1); PG8_STAGE(PG8_SB(0, 0), b2, voffB); PG8_STAGE(PG8_SB(0, 1), b2 + hstepB, voffB); PG8_STAGE(PG8_SA(0, 0), a2, voffA);
            PG8_WAIT_V(8); PG8_WAIT_L(0); PG8_BAR; PG8_MMA(1, 0, At, B0); PG8_MMA(1, 1, At, B1); PG8_BAR; PG8_SCHED;
            PG8_LDB(B0, 1, 0); PG8_LDB(B1, 1, 1); PG8_SCHED; PG8_LDA(At, 1, 0); PG8_STAGE(PG8_SA(0, 1), a2 + hstepA, voffA);
            PG8_WAIT_V(8); PG8_WAIT_L(0); PG8_BAR; PG8_MMA(0, 0, At, B0); PG8_MMA(0, 1, At, B1); PG8_BAR; PG8_SCHED;
            PG8_LDA(At, 1, 1); PG8_STAGE(PG8_SB(1, 0), b3, voffB); PG8_STAGE(PG8_SB(1, 1), b3 + hstepB, voffB); PG8_STAGE(PG8_SA(1, 0), a3, voffA);
            PG8_WAIT_V(8); PG8_WAIT_L(0); PG8_BAR; PG8_MMA(1, 0, At, B0); PG8_MMA(1, 1, At, B1); PG8_BAR; PG8_SCHED;
            } else {
            PG8_LDB(B0, 0, 0); PG8_SCHED; PG8_LDA(At, 0, 0); PG8_STAGE(PG8_SA(1, 1), a1 + hstepA, voffA);
            PG8_WAIT_L(8); PG8_BAR; PG8_WAIT_L(0); PG8_MMA(0, 0, At, B0); PG8_BAR; PG8_SCHED;
            PG8_LDB(B1, 0, 1); PG8_STAGE(PG8_SB(0, 0), b2, voffB);
            PG8_BAR; PG8_WAIT_L(0); PG8_MMA(0, 1, At, B1); PG8_BAR;
            PG8_LDA(At, 0, 1); PG8_STAGE(PG8_SA(0, 0), a2, voffA);
            PG8_BAR; PG8_WAIT_L(0); PG8_MMA(1, 0, At, B0); PG8_BAR; PG8_SCHED;
            PG8_STAGE(PG8_SB(0, 1), b2 + hstepB, voffB);
            PG8_WAIT_V(6); PG8_BAR; PG8_MMA(1, 1, At, B1); PG8_BAR;
            PG8_LDB(B0, 1, 0); PG8_SCHED; PG8_LDA(At, 1, 0); PG8_STAGE(PG8_SA(0, 1), a2 + hstepA, voffA);
            PG8_WAIT_L(8); PG8_BAR; PG8_WAIT_L(0); PG8_MMA(0, 0, At, B0); PG8_BAR; PG8_SCHED;
            PG8_LDB(B1, 1, 1); PG8_STAGE(PG8_SB(1, 0), b3, voffB);
            PG8_BAR; PG8_WAIT_L(0); PG8_MMA(0, 1, At, B1); PG8_BAR;
            PG8_LDA(At, 1, 1); PG8_STAGE(PG8_SA(1, 0), a3, voffA);
            PG8_BAR; PG8_WAIT_L(0); PG8_MMA(1, 0, At, B0); PG8_BAR; PG8_SCHED;
            PG8_STAGE(PG8_SB(1, 1), b3 + hstepB, voffB);
            PG8_WAIT_V(6); PG8_BAR; PG8_MMA(1, 1, At, B1); PG8_BAR;
            }
        }
        if constexpr (ALIGN_EPI) { if (wr == 0) PG8_BAR; }
        if constexpr (!Epi::AFTER_DRAIN) { E(acc, cur, wr, wc, fr, fq); S.done(cur); }
        if (!has_next) break;
#pragma unroll
        for (int a = 0; a < 2; ++a)
#pragma unroll
            for (int b = 0; b < 2; ++b)
#pragma unroll
                for (int m = 0; m < 4; ++m)
#pragma unroll
                    for (int n = 0; n < 2; ++n) acc[a][b][m][n] = (f32x4){0.f, 0.f, 0.f, 0.f};
        cur = nxt; cA = nA; cB = nB; ++ui;
        if constexpr (ALIGN_EPI) { if (wr == 1) PG8_BAR; }
    }
    PG8_WAIT_V(0);
    if constexpr (!ALIGN_EPI) { if (wr == 0) PG8_BAR; }
    PG8_BAR;
    if constexpr (Epi::AFTER_DRAIN) { E.fused(acc, cur, wr, wc, fr, fq, lds, wid, lane); S.done(cur); }
#undef PG8_SA
#undef PG8_SB
#undef PG8_STAGE
#undef PG8_LDA
#undef PG8_LDB
#undef PG8_MMA
#undef PG8_WAIT_V
#undef PG8_WAIT_L
#undef PG8_BAR
#undef PG8_SCHED
}
}
#define LAS __attribute__((address_space(3)))
typedef unsigned short bf16;
typedef short bf16x8 __attribute__((ext_vector_type(8)));
typedef float f32x4 __attribute__((ext_vector_type(4)));
typedef float f32x16 __attribute__((ext_vector_type(16)));
typedef unsigned u32x4 __attribute__((ext_vector_type(4)));
typedef unsigned u32x2 __attribute__((ext_vector_type(2)));
typedef short v4i16_t __attribute__((ext_vector_type(4)));
constexpr int NWAVES = 8, NTHREADS = 512;
constexpr int SEQ = 2048, BATCH = 16, M = BATCH * SEQ, D = 1024, NH = 16, DFF = 2816, DFF2 = 5632;
constexpr int NLAT = 768, KVR = 256, QR = 384, NQ = 1536;
constexpr float ALPHA = 1.4142135623730951f;
constexpr float LN_EPS = 1e-5f, RMS_EPS = 1e-6f;
constexpr float LOG2E = 1.4426950408889634f;
constexpr size_t MiB = 1u << 20;
constexpr size_t WS_ROPE = 1 * MiB;
constexpr size_t WS_WQKV = 2 * MiB, WS_WOA = 8 * MiB, WS_WLAT = 10 * MiB, WS_WUKV = 12 * MiB, WS_WUQ = 13 * MiB, WS_WOB = 15 * MiB;
constexpr size_t WS_WIN0 = 17 * MiB, WS_WIN1 = 28 * MiB, WS_WOUT0 = 39 * MiB, WS_WOUT1 = 39 * MiB + 5632 * 1024, WS_WEND = 50 * MiB;
constexpr size_t WS_RS = 52 * MiB;
constexpr size_t WS_KR = 53 * MiB;
constexpr size_t WS_LSE = 56 * MiB;
constexpr size_t WS_XB = 62 * MiB;
constexpr size_t WS_SP = 64 * MiB + 272 * 1024;
constexpr size_t WS_R1 = WS_XB + WS_SP, WS_R2 = WS_R1 + WS_SP, WS_R3 = WS_R2 + WS_SP, WS_R4 = WS_R3 + WS_SP, WS_R5 = WS_R4 + WS_SP, WS_R6 = WS_R5 + WS_SP, WS_END = 512 * MiB;
static_assert(WS_R6 + 64 * MiB <= WS_END && WS_R1 + (size_t)32768 * 2816 * 2 <= WS_R4 && WS_R4 + (size_t)32768 * 1536 * 2 <= WS_R6 + 64 * MiB, "d_ws map");
constexpr int LDS_OST = 104448, OST_WAVE = 32 * 144;
constexpr int LDS_MISC = LDS_OST + 8 * OST_WAVE;
constexpr int LDS_BYTES = LDS_MISC + 2048;

__device__ __forceinline__ unsigned f2bf(float f) { unsigned u = __builtin_bit_cast(unsigned, f); return (u + 0x7fffu + ((u >> 16) & 1u)) >> 16; }
__device__ __forceinline__ unsigned pk2(float lo, float hi) { return f2bf(lo) | (f2bf(hi) << 16); }
__device__ __forceinline__ float bf_lo(unsigned w) { return __builtin_bit_cast(float, w << 16); }
__device__ __forceinline__ float bf_hi(unsigned w) { return __builtin_bit_cast(float, w & 0xffff0000u); }
__device__ __forceinline__ float wave_sum(float v) {
#pragma unroll
    for (int o = 1; o < 64; o <<= 1) v += __shfl_xor(v, o);
    return v;
}
__device__ __forceinline__ float silu_mul(float g, float v) { return g * __builtin_amdgcn_rcpf(1.0f + __expf(-g)) * v; }

#define GAS __attribute__((address_space(1)))
typedef GAS unsigned gu32;
typedef GAS unsigned long long gu64;
#define RLX_AGENT __ATOMIC_RELAXED, __HIP_MEMORY_SCOPE_AGENT
#define LDS_WAIT() asm volatile("s_waitcnt lgkmcnt(0)" ::: "memory")
#define VM_WAIT() asm volatile("s_waitcnt vmcnt(0)" ::: "memory")
#define XB_TMO      128
#define XB_XCNT(j)  (256  + 64 * (j))
#define XB_XSUB(j)  (1280 + 64 * (j))
#define XB_XGEN(j)  (2304 + 64 * (j))
#define XB_TOP      3328
#define XB_TOPGEN   3392
#define XCD_BAR_WORDS 3456
#define XB_SPIN_CAP (1u << 18)

__device__ __forceinline__ unsigned xb_ld(unsigned* p)              { return __hip_atomic_load(p, __ATOMIC_RELAXED, __HIP_MEMORY_SCOPE_AGENT); }
__device__ __forceinline__ unsigned xb_add(unsigned* p, unsigned v) { return __hip_atomic_fetch_add(p, v, __ATOMIC_RELAXED, __HIP_MEMORY_SCOPE_AGENT); }
__device__ __forceinline__ unsigned xb_xcc_id() { return (unsigned)__builtin_amdgcn_s_getreg((3 << 11) | 20) & 0xFu; }
#define XB_SPIN(cond, bar) do { unsigned _sp = 0; while (cond) { __builtin_amdgcn_s_sleep(1); \
    if ((++_sp & 255u) == 0u) { if (xb_ld(&(bar)[XB_TMO])) break; if (_sp > XB_SPIN_CAP) { atomicAdd(&(bar)[XB_TMO], 1u); break; } } } } while (0)

struct XcdBarrier {
    unsigned* bar; unsigned x;
    volatile LAS unsigned* st;
};

__device__ __forceinline__ XcdBarrier xcd_barrier_post(unsigned* bar, volatile LAS unsigned* st) {
    XcdBarrier b; b.bar = bar; b.x = xb_xcc_id(); b.st = st;
    if (threadIdx.x == 0) (void)xb_add(&bar[XB_XCNT(b.x)], 1u);
    return b;
}
__device__ __forceinline__ void xcd_barrier_complete(unsigned* bar, unsigned x, unsigned& nloc, unsigned& nx) {
    const unsigned G = gridDim.x * gridDim.y * gridDim.z;
    unsigned sum, cnt, mine, sp = 0u;
    for (;;) {
        sum = 0u; cnt = 0u; mine = 0u;
#pragma unroll
        for (unsigned j = 0; j < 16; ++j) { const unsigned c = xb_ld(&bar[XB_XCNT(j)]); sum += c; cnt += (c > 0u) ? 1u : 0u; mine = (j == x) ? c : mine; }
        if (sum == G) break;
        __builtin_amdgcn_s_sleep(1);
        if ((++sp & 255u) == 0u) { if (xb_ld(&bar[XB_TMO])) break; if (sp > XB_SPIN_CAP) { atomicAdd(&bar[XB_TMO], 1u); break; } }
    }
    nloc = mine > 0u ? mine : 1u; nx = cnt > 0u ? cnt : 1u;
}

__device__ __forceinline__ void xcd_barrier(const XcdBarrier& b) {
    asm volatile("s_waitcnt vmcnt(0)" ::: "memory");
    __syncthreads();
    if (threadIdx.x == 0) {
        unsigned* bar = b.bar;
        __builtin_amdgcn_s_waitcnt(0);
        unsigned nloc = b.st[0], nx = b.st[1];
        if (nloc == 0u) { xcd_barrier_complete(bar, b.x, nloc, nx); b.st[0] = nloc; b.st[1] = nx; }
        const unsigned old = xb_add(&bar[XB_XSUB(b.x)], 1u);
        const unsigned gen = old / nloc;
        if (old + 1u == (gen + 1u) * nloc) {
            __builtin_amdgcn_fence(__ATOMIC_RELEASE, "agent");
            asm volatile("s_waitcnt vmcnt(0)" ::: "memory");
            const unsigned og = xb_add(&bar[XB_TOP], 1u);
            const unsigned tg = og / nx;
            if (og + 1u == (tg + 1u) * nx) xb_add(&bar[XB_TOPGEN], 1u);
            else XB_SPIN(xb_ld(&bar[XB_TOPGEN]) == tg, bar);
            __builtin_amdgcn_fence(__ATOMIC_ACQUIRE, "agent");
            xb_add(&bar[XB_XGEN(b.x)], 1u);
            asm volatile("s_waitcnt vmcnt(0)" ::: "memory");
        } else {
            XB_SPIN(xb_ld(&bar[XB_XGEN(b.x)]) == gen, bar);
            __builtin_amdgcn_fence(__ATOMIC_ACQUIRE, "agent");
            asm volatile("s_waitcnt vmcnt(0)" ::: "memory");
        }
    }
    __syncthreads();
}


constexpr size_t WS_BAR = 0;
#define GRID_BAR() do { XcdBarrier b_; b_.bar = (unsigned*)(kargs()->ws + WS_BAR); b_.x = xb_xcc_id(); b_.st = (volatile LAS unsigned*)(lds + LDS_MISC); xcd_barrier(b_); } while (0)

struct PrepSrc { const float* p0; const float* p1; const float* p2; const float* gain; };
template <int MODE> __device__ __forceinline__ void prep_item(const PrepSrc S, int K, int N, bf16* WT, LAS float* scr, int item, int lane) {
    const int nblk = N / 32, kb = item / nblk, nb = item % nblk, k0 = 64 * kb, n0 = 32 * nb;
    const int n = n0 + (lane & 31);
    const float* cp = nullptr; int ld = 0;
    if (MODE == 0) { cp = S.p0 + n; ld = N; }
    else if (MODE == 1) { if (n < 256) { cp = S.p0 + n; ld = 256; } else if (n < 640) { cp = S.p1 + (n - 256); ld = 384; } else if (n < 672) { const int p = n - 640; cp = S.p2 + ((p >> 1) + 16 * (p & 1)); ld = 32; } }
    else if (MODE == 2) { if (n < 1024) { cp = S.p0 + n; } else { cp = S.p1 + (n - 1024); } ld = 1024; }
    else if (MODE == 3) { const int h = n / 96, o = n % 96; int oc; if (o < 64) oc = o; else { const int p = o - 64; oc = 64 + (p >> 1) + 16 * (p & 1); } cp = S.p0 + h * 96 + oc; ld = 1536; }
    else { const int pn = n >> 8, o = n & 255; const int f = 128 * pn + (o & 127); cp = S.p0 + ((o < 128) ? f : 2816 + f); ld = 5632; }
#pragma unroll
    for (int i = 0; i < 32; ++i) { const int kk = 2 * i + (lane >> 5); float v = cp ? __builtin_nontemporal_load(cp + (size_t)(k0 + kk) * ld) : 0.f; if (MODE == 2 || MODE == 3) v *= S.gain[k0 + kk]; scr[kk * 33 + (lane & 31)] = v; }
    asm volatile("s_waitcnt lgkmcnt(0)" ::: "memory");
    const int c = lane & 7;
#pragma unroll
    for (int j = 0; j < 4; ++j) { const int nn = (lane >> 3) + 8 * j; const LAS float* s = scr + (8 * c) * 33 + nn;
        u32x4 o; o.x = pk2(s[0 * 33], s[1 * 33]); o.y = pk2(s[2 * 33], s[3 * 33]); o.z = pk2(s[4 * 33], s[5 * 33]); o.w = pk2(s[6 * 33], s[7 * 33]);
        *(u32x4*)(WT + (size_t)(n0 + nn) * K + k0 + 8 * c) = o; }
    asm volatile("s_waitcnt lgkmcnt(0)" ::: "memory");
}

__device__ __forceinline__ void ln_rows(const float* xin, const bf16* xinb, const bf16* add, const float* g, const float* b, float* xout, bf16* xb, int gw, int ngw, int lane) {
    constexpr int R = 4;
    f32x4 gv[4], bv[4];
#pragma unroll
    for (int j = 0; j < 4; ++j) { gv[j] = *((const f32x4*)g + lane + 64 * j); bv[j] = *((const f32x4*)b + lane + 64 * j); }
    const int rpw = ((M + ngw - 1) / ngw + R - 1) / R * R; const int mend = (gw + 1) * rpw < M ? (gw + 1) * rpw : M;
    for (int m0 = gw * rpw; m0 < mend; m0 += R) {
        f32x4 v[R][4]; u32x2 av[R][4];
#pragma unroll
        for (int q = 0; q < R; ++q) { const int m = m0 + q;
            const u32x2* ar = (const u32x2*)(add + (size_t)m * D) + lane;
#pragma unroll
            for (int j = 0; j < 4; ++j) av[q][j] = __builtin_nontemporal_load(&ar[64 * j]);
            if (xin) { const f32x4* xr = (const f32x4*)(xin + (size_t)m * D) + lane;
#pragma unroll
                for (int j = 0; j < 4; ++j) v[q][j] = __builtin_nontemporal_load(&xr[64 * j]);
            } else { const u32x2* xr = (const u32x2*)(xinb + (size_t)m * D) + lane;
#pragma unroll
                for (int j = 0; j < 4; ++j) { const u32x2 x = __builtin_nontemporal_load(&xr[64 * j]); v[q][j][0] = bf_lo(x.x); v[q][j][1] = bf_hi(x.x); v[q][j][2] = bf_lo(x.y); v[q][j][3] = bf_hi(x.y); } } }
        float s[R], s2[R];
#pragma unroll
        for (int q = 0; q < R; ++q) { s[q] = 0.f; s2[q] = 0.f;
#pragma unroll
            for (int j = 0; j < 4; ++j) { const u32x2 a = av[q][j];
                v[q][j][0] = ALPHA * v[q][j][0] + bf_lo(a.x); v[q][j][1] = ALPHA * v[q][j][1] + bf_hi(a.x); v[q][j][2] = ALPHA * v[q][j][2] + bf_lo(a.y); v[q][j][3] = ALPHA * v[q][j][3] + bf_hi(a.y);
                s[q] += (v[q][j][0] + v[q][j][1]) + (v[q][j][2] + v[q][j][3]);
                s2[q] += (v[q][j][0] * v[q][j][0] + v[q][j][1] * v[q][j][1]) + (v[q][j][2] * v[q][j][2] + v[q][j][3] * v[q][j][3]); } }
#pragma unroll
        for (int o = 1; o < 64; o <<= 1) {
#pragma unroll
            for (int q = 0; q < R; ++q) { s[q] += __shfl_xor(s[q], o); s2[q] += __shfl_xor(s2[q], o); } }
#pragma unroll
        for (int q = 0; q < R; ++q) { const int m = m0 + q;
            const float mean = s[q] * (1.f / D); const float var = fmaxf(s2[q] * (1.f / D) - mean * mean, 0.f); const float rstd = 1.f / sqrtf(var + LN_EPS);
            f32x4* orow = xout ? (f32x4*)(xout + (size_t)m * D) + lane : nullptr; u32x2* brow = xb ? (u32x2*)(xb + (size_t)m * D) + lane : nullptr;
#pragma unroll
            for (int j = 0; j < 4; ++j) { const f32x4 o = (v[q][j] - mean) * rstd * gv[j] + bv[j];
                if (xout) __builtin_nontemporal_store(o, &orow[64 * j]);
                if (xb) { u32x2 w; w.x = pk2(o[0], o[1]); w.y = pk2(o[2], o[3]); brow[64 * j] = w; } } }
    }
}

__device__ __forceinline__ int crow(int r, int hi) { return (r & 3) + 8 * (r >> 2) + 4 * hi; }
__device__ __forceinline__ unsigned cvtpk(float lo, float hi) { typedef float f2 __attribute__((ext_vector_type(2))); typedef __bf16 b2 __attribute__((ext_vector_type(2))); f2 v = {lo, hi}; b2 b = __builtin_convertvector(v, b2); return __builtin_bit_cast(unsigned, b); }
typedef short s16x4 __attribute__((ext_vector_type(4)));
__device__ __forceinline__ float xhalf(float v) { const unsigned u = __float_as_uint(v); auto rr = __builtin_amdgcn_permlane32_swap(u, u, false, false); return __uint_as_float((threadIdx.x & 32) ? rr[0] : rr[1]); }
__device__ __forceinline__ s16x4 vtr(const LAS unsigned char* p) { return __builtin_bit_cast(s16x4, __builtin_amdgcn_ds_read_tr16_b64_v4i16((LAS v4i16_t*)p)); }

template <bool NT> __device__ __forceinline__ void store_o_rows(LAS unsigned char* stg, const f32x16 (&o)[2], float inv, bf16* Ohead, int tok0, int tokstep, int lane) {
    const int r32 = lane & 31, hi = lane >> 5;
#pragma unroll
    for (int db = 0; db < 2; ++db)
#pragma unroll
        for (int g = 0; g < 4; ++g) { u32x2 wv; wv.x = cvtpk(o[db][4 * g] * inv, o[db][4 * g + 1] * inv); wv.y = cvtpk(o[db][4 * g + 2] * inv, o[db][4 * g + 3] * inv);
            *(LAS u32x2*)(stg + r32 * 144 + (32 * db + 8 * g + 4 * hi) * 2) = wv; }
    asm volatile("s_waitcnt lgkmcnt(0)" ::: "memory");
#pragma unroll
    for (int i = 0; i < 4; ++i) { const int row = (lane >> 3) + 8 * i, ch = lane & 7; const u32x4 v = *(const LAS u32x4*)(stg + row * 144 + ch * 16);
        if (NT) __builtin_nontemporal_store(v, (u32x4*)(Ohead + (size_t)(tok0 + row * tokstep) * 1024 + ch * 8)); else *(u32x4*)(Ohead + (size_t)(tok0 + row * tokstep) * 1024 + ch * 8) = v; }
    asm volatile("s_waitcnt lgkmcnt(0)" ::: "memory");
}

template <int DQK> __device__ __forceinline__ void attn_unit(LAS unsigned char* lds, int mode, int b, int h, int blk, const bf16* Qp, int ldq, int qcol,
                                                            const bf16* Kp, const bf16* KRp, const bf16* Vp, bf16* Op, float* lsep) {
    constexpr int KSTR = DQK * 2 + 16, KBUF = 64 * KSTR, VBUF = 64 * 128, NKS = DQK / 16;
    const int tid = pg8::pg8_ltid(), lane = tid & 63, r32 = lane & 31, hi = lane >> 5; const int w = __builtin_amdgcn_readfirstlane(tid >> 6);
    LAS unsigned char* Kl = lds; LAS unsigned char* Vl = lds + 2 * KBUF;
    int d = 1, res = 0, qs0 = 0, ks0 = 0, nt = 4, qs_w, res_w, maxback = 128; float slope2 = 0.f;
    if (mode == 0) { qs0 = 256 * blk; nt = 4 * (blk + 1); maxback = 1 << 30; }
    else { const float sl = exp2f(-0.5f * (float)(h + 1)) * LOG2E;
        if (mode == 1) { qs0 = 256 * blk; ks0 = qs0 >= 128 ? qs0 - 128 : 0; nt = (qs0 + 256 - ks0) >> 6; slope2 = sl; }
        else if (mode == 2) { d = 4; res = blk >> 1; qs0 = 256 * (blk & 1); ks0 = qs0 >= 128 ? qs0 - 128 : 0; nt = (qs0 + 256 - ks0) >> 6; slope2 = sl * 4.f; }
        else { d = 16; nt = 4; slope2 = sl * 16.f; } }
    if (mode == 3) { qs_w = 32 * (w & 3); res_w = 2 * blk + (w >> 2); } else { qs_w = qs0 + 32 * w; res_w = res; }
    const int tokbase = b * SEQ;
    const int tq = tokbase + (qs_w + r32) * d + res_w;
    const int srow = tid >> 3, sch = tid & 7, rrow = (tid >> 2) & 63, rch = tid & 3;
    u32x4 kreg0, vreg0, rreg0, kreg1, vreg1, rreg1;
#define ATT_TOK(t, j) (mode == 3 ? tokbase + (32 * (t) + ((j) & 31)) * 16 + 2 * blk + ((j) >> 5) : tokbase + (ks0 + 64 * (t) + (j)) * d + res)
#define ATT_LOAD(S, t) do { const size_t tk = (size_t)ATT_TOK(t, srow); const size_t hk_ = ((size_t)(b * 16 + h) * 2048 + (tk - tokbase)) * 64 + sch * 8; kreg##S = *(const u32x4*)(Kp + hk_); vreg##S = *(const u32x4*)(Vp + hk_); \
        if (DQK == 96 && tid < 256) { const size_t tr = (size_t)ATT_TOK(t, rrow); rreg##S = *(const u32x4*)(KRp + tr * 32 + rch * 8); } } while (0)
#define ATT_STORE(S, buf) do { *(LAS u32x4*)(Kl + (buf) * KBUF + srow * KSTR + sch * 16) = kreg##S; \
        *(LAS u32x4*)(Vl + (buf) * VBUF + srow * 128 + (((sch >> 2) ^ ((srow >> 1) & 1)) * 64) + (sch & 3) * 16) = vreg##S; \
        if (DQK == 96 && tid < 256) *(LAS u32x4*)(Kl + (buf) * KBUF + rrow * KSTR + 128 + rch * 16) = rreg##S; } while (0)
    bf16x8 qf[NKS];
#pragma unroll
    for (int d0 = 0; d0 < NKS; ++d0) qf[d0] = *(const bf16x8*)(Qp + ((size_t)(b * 16 + h) * 2048 + (tq - tokbase)) * DQK + d0 * 16 + hi * 8);
    const bool rev = (mode != 0);
#define ATT_SEQ(i) (rev ? nt - 1 - (i) : (i))
    ATT_LOAD(0, ATT_SEQ(0));
    ATT_LOAD(1, ATT_SEQ(1));
    ATT_STORE(0, 0);
    __syncthreads();
    const float NEG = -1e30f, THR = 8.0f;
    float mrun = 0.f, lrun = 0.f; f32x16 o[2]; o[0] = (f32x16){}; o[1] = (f32x16){};
    bool first = true;
    const int q4 = (lane & 15) >> 2, p4 = lane & 3, g1 = (lane >> 4) & 1;
    const int voff = q4 * 128 + g1 * 32 + p4 * 8 + hi * 4 * 128;
    const int vsw = (q4 >> 1) & 1;
    auto tile_compute = [&](const int t, const int buf) __attribute__((always_inline)) {
        const int bA = rev ? 1 : 0, bB = 1 - bA;
        bool actA, actB, intA, intB; int kbA, kbB;
#define ATT_CLASS(b2, act_, int_, kb_) do { \
            if (mode == 0) { kb_ = 64 * t + 32 * (b2); act_ = kb_ <= qs_w + 31; int_ = kb_ + 31 <= qs_w; } \
            else if (mode == 3) { kb_ = 32 * t; act_ = ((b2) == (w >> 2)) && (32 * t <= qs_w + 31); int_ = kb_ + 31 <= qs_w; } \
            else { kb_ = ks0 + 64 * t + 32 * (b2); act_ = (kb_ <= qs_w + 31) && (kb_ + 31 >= qs_w - 128); int_ = (kb_ + 31 <= qs_w) && (qs_w + 31 - kb_ <= 128); } } while (0)
        ATT_CLASS(bA, actA, intA, kbA); ATT_CLASS(bB, actB, intB, kbB);
#define ATT_INIT(a, kb_, int_) do { const int base_ = (qs_w + r32) - (kb_) - 4 * hi; const float t0_ = -(slope2 * (float)base_ + mrun); \
            if (int_) { _Pragma("unroll") for (int r = 0; r < 16; ++r) a[r] = fmaf(slope2, (float)((r & 3) + 8 * (r >> 2)), t0_); } \
            else { _Pragma("unroll") for (int r = 0; r < 16; ++r) { const int delta_ = base_ - ((r & 3) + 8 * (r >> 2)); a[r] = ((unsigned)delta_ <= (unsigned)maxback) ? fmaf(slope2, (float)((r & 3) + 8 * (r >> 2)), t0_) : NEG; } } } while (0)
#define ATT_KREAD(kf, b2) do { const LAS unsigned char* kp_ = Kl + buf * KBUF + (32 * (b2) + r32) * KSTR + hi * 16; _Pragma("unroll") for (int d0 = 0; d0 < NKS; ++d0) kf[d0] = *(const LAS bf16x8*)(kp_ + d0 * 32); } while (0)
#define ATT_VREAD(vl, vh, b2) do { _Pragma("unroll") for (int s = 0; s < 2; ++s) { const LAS unsigned char* vp_ = Vl + buf * VBUF + voff + (32 * (b2) + 16 * s) * 128; \
            _Pragma("unroll") for (int db = 0; db < 2; ++db) { vl[s][db] = vtr(vp_ + ((db ^ vsw) * 64)); vh[s][db] = vtr(vp_ + 8 * 128 + ((db ^ vsw) * 64)); } } } while (0)
#define ATT_PACK(pf, e) do { _Pragma("unroll") for (int s = 0; s < 2; ++s) { u32x4 pw_; pw_.x = cvtpk(e[8 * s + 0], e[8 * s + 1]); pw_.y = cvtpk(e[8 * s + 2], e[8 * s + 3]); pw_.z = cvtpk(e[8 * s + 4], e[8 * s + 5]); pw_.w = cvtpk(e[8 * s + 6], e[8 * s + 7]); pf[s] = __builtin_bit_cast(bf16x8, pw_); } } while (0)
#define ATT_VF(vl, vh, s, db) (bf16x8){vl[s][db][0], vl[s][db][1], vl[s][db][2], vl[s][db][3], vh[s][db][0], vh[s][db][1], vh[s][db][2], vh[s][db][3]}
#define ATT_SB() __builtin_amdgcn_sched_barrier(0)
#define ATT_EXPS(X, lo, hi_, ls_) do { _Pragma("unroll") for (int r = (lo); r < (hi_); ++r) { const float ev_ = __builtin_amdgcn_exp2f(X[r]); X[r] = ev_; ls_ += ev_; } } while (0)
#define ATT_MAX16(X, m_) do { m_ = NEG; _Pragma("unroll") for (int r = 0; r < 16; ++r) m_ = fmaxf(m_, X[r]); m_ = fmaxf(m_, xhalf(m_)); } while (0)
        if (actA && actB && !first) {
            f32x16 pA, pB; float lsA = 0.f, lsB = 0.f, dlA = 0.f, dlB = 0.f; bool needA = false, needB = false; bf16x8 kfa[NKS], kfb[NKS];
            ATT_KREAD(kfa, bA); ATT_INIT(pA, kbA, intA); ATT_INIT(pB, kbB, intB);
            ATT_SB();
#pragma unroll
            for (int d0 = 0; d0 < NKS; ++d0) pA = __builtin_amdgcn_mfma_f32_32x32x16_bf16(kfa[d0], qf[d0], pA, 0, 0, 0);
            ATT_KREAD(kfb, bB);
            ATT_SB();
            s16x4 vla[2][2], vha[2][2], vlb[2][2], vhb[2][2];
#pragma unroll
            for (int d0 = 0; d0 < NKS; ++d0) {
                pB = __builtin_amdgcn_mfma_f32_32x32x16_bf16(kfb[d0], qf[d0], pB, 0, 0, 0);
                if (d0 == 0) { float mtA; ATT_MAX16(pA, mtA); needA = __any(mtA > THR);
                    if (needA) { dlA = fmaxf(mtA, 0.f); const float alpha = __builtin_amdgcn_exp2f(-dlA); mrun += dlA; lrun *= alpha;
#pragma unroll
                        for (int r = 0; r < 16; ++r) { o[0][r] *= alpha; o[1][r] *= alpha; pA[r] -= dlA; } } }
                else if (NKS == 6) { if (d0 <= 4) ATT_EXPS(pA, 4 * (d0 - 1), 4 * d0, lsA); }
                else { if (d0 == 1) ATT_EXPS(pA, 0, 6, lsA); else if (d0 == 2) ATT_EXPS(pA, 6, 11, lsA); else ATT_EXPS(pA, 11, 16, lsA); }
                if (d0 == NKS - 1) ATT_VREAD(vla, vha, bA);
                ATT_SB();
            }
            bf16x8 pfA[2], pfB[2];
            ATT_PACK(pfA, pA);
            ATT_SB();
#pragma unroll
            for (int s = 0; s < 2; ++s)
#pragma unroll
                for (int db = 0; db < 2; ++db) {
                    o[db] = __builtin_amdgcn_mfma_f32_32x32x16_bf16(ATT_VF(vla, vha, s, db), pfA[s], o[db], 0, 0, 0);
                    const int g = 2 * s + db;
                    if (g == 0) { if (needA) {
#pragma unroll
                            for (int r = 0; r < 16; ++r) pB[r] -= dlA; }
                        float mtB; ATT_MAX16(pB, mtB); needB = __any(mtB > THR);
                        if (needB) { dlB = fmaxf(mtB, 0.f);
#pragma unroll
                            for (int r = 0; r < 16; ++r) pB[r] -= dlB; } }
                    else if (g == 1) ATT_EXPS(pB, 0, 6, lsB); else if (g == 2) ATT_EXPS(pB, 6, 11, lsB); else ATT_EXPS(pB, 11, 16, lsB);
                    if (g == 3) ATT_VREAD(vlb, vhb, bB);
                    ATT_SB();
                }
            ATT_PACK(pfB, pB);
            if (needB) { const float alpha = __builtin_amdgcn_exp2f(-dlB); mrun += dlB; lrun = (lrun + lsA) * alpha;
#pragma unroll
                for (int r = 0; r < 16; ++r) { o[0][r] *= alpha; o[1][r] *= alpha; } }
            else lrun += lsA;
#pragma unroll
            for (int s = 0; s < 2; ++s)
#pragma unroll
                for (int db = 0; db < 2; ++db) o[db] = __builtin_amdgcn_mfma_f32_32x32x16_bf16(ATT_VF(vlb, vhb, s, db), pfB[s], o[db], 0, 0, 0);
            lrun += lsB;
        } else if (actA || actB) {
#pragma unroll
            for (int k2 = 0; k2 < 2; ++k2) if (k2 == 0 ? actA : actB) {
                const int b2 = k2 == 0 ? bA : bB; const int kbx = k2 == 0 ? kbA : kbB; const bool intx = k2 == 0 ? intA : intB;
                f32x16 a; bf16x8 kf[NKS]; s16x4 vl[2][2], vh[2][2];
                ATT_KREAD(kf, b2); ATT_INIT(a, kbx, intx);
#pragma unroll
                for (int d0 = 0; d0 < NKS; ++d0) a = __builtin_amdgcn_mfma_f32_32x32x16_bf16(kf[d0], qf[d0], a, 0, 0, 0);
                ATT_VREAD(vl, vh, b2);
                float mt; ATT_MAX16(a, mt);
                if (first || __any(mt > 0.f)) {
                    const float dl = first ? mt : fmaxf(mt, 0.f);
                    const float alpha = first ? 1.0f : __builtin_amdgcn_exp2f(-dl); mrun += dl; lrun *= alpha;
#pragma unroll
                    for (int r = 0; r < 16; ++r) { o[0][r] *= alpha; o[1][r] *= alpha; a[r] -= dl; }
                    first = false;
                }
                float ls = 0.f;
                ATT_EXPS(a, 0, 16, ls);
                lrun += ls;
                bf16x8 pf[2]; ATT_PACK(pf, a);
#pragma unroll
                for (int s = 0; s < 2; ++s)
#pragma unroll
                    for (int db = 0; db < 2; ++db) o[db] = __builtin_amdgcn_mfma_f32_32x32x16_bf16(ATT_VF(vl, vh, s, db), pf[s], o[db], 0, 0, 0);
            }
        }
    };
    for (int it = 0; it < nt; it += 2) {
        if (it + 2 < nt) ATT_LOAD(0, ATT_SEQ(it + 2));
        tile_compute(ATT_SEQ(it), 0);
        ATT_STORE(1, 1);
        __syncthreads();
        if (it + 3 < nt) ATT_LOAD(1, ATT_SEQ(it + 3));
        tile_compute(ATT_SEQ(it + 1), 1);
        if (it + 2 < nt) ATT_STORE(0, 0);
        __syncthreads();
    }
    const float ltot = lrun + xhalf(lrun); const float inv = 1.0f / ltot;
    store_o_rows<false>(lds + LDS_OST + w * OST_WAVE, o, inv, Op + h * 64, tokbase + qs_w * d + res_w, d, lane);
    if (lsep && hi == 0) lsep[(size_t)tq * 16 + h] = mrun + log2f(ltot);
#undef ATT_TOK
#undef ATT_SEQ
#undef ATT_CLASS
#undef ATT_EXPS
#undef ATT_MAX16
#undef ATT_INIT
#undef ATT_KREAD
#undef ATT_VREAD
#undef ATT_PACK
#undef ATT_VF
#undef ATT_SB
#undef ATT_LOAD
#undef ATT_STORE
}

__device__ __forceinline__ void dil_phase(LAS unsigned char* lds, int bhbase, int member, const bf16* Qp, const bf16* Kp, const bf16* Vp, bf16* Opart, size_t ostride, float* lse) {
    constexpr int KSTR = 144, KBYTES = 384 * KSTR, NKS = 4;
    const int tid = pg8::pg8_ltid(), lane = tid & 63, r32 = lane & 31, hi = lane >> 5; const int w = __builtin_amdgcn_readfirstlane(tid >> 6);
    LAS unsigned char* Kl = lds; LAS unsigned char* Vl = lds + KBYTES;
    const int srow = tid >> 3, sch = tid & 7;
    const int q4 = (lane & 15) >> 2, p4 = lane & 3, g1 = (lane >> 4) & 1;
    const int voff = q4 * 128 + g1 * 32 + p4 * 8 + hi * 4 * 128, vsw = (q4 >> 1) & 1;
    const float NEG = -1e30f;
    u32x4 kr[6], vr[6]; bf16x8 qn[NKS];
#define DIL_GEOM(k) const int st_ = (k) / 3, mode = 1 + (k) % 3, blk = (member + st_) & 7, bh = bhbase + st_; const int b = bh >> 4, h = bh & 15, tokbase = b * SEQ; int d, res, qs0, ks0, nrows; \
        if (mode == 1) { d = 1; res = 0; qs0 = 256 * blk; ks0 = qs0 >= 128 ? qs0 - 128 : 0; nrows = qs0 + 256 - ks0; } \
        else if (mode == 2) { d = 4; res = blk >> 1; qs0 = 256 * (blk & 1); ks0 = qs0 >= 128 ? qs0 - 128 : 0; nrows = qs0 + 256 - ks0; } \
        else { d = 16; res = 0; qs0 = 0; ks0 = 0; nrows = 256; } \
        const int qs_w = mode == 3 ? 32 * (w & 3) : qs0 + 32 * w, res_w = mode == 3 ? 2 * blk + (w >> 2) : res; \
        const int tq = tokbase + (qs_w + r32) * d + res_w;
#define DIL_FETCH(k) do { DIL_GEOM(k) (void)qs_w; \
        _Pragma("unroll") for (int jj = 0; jj < 6; ++jj) if (64 * jj < nrows) { const int row = srow + 64 * jj; \
            const size_t tk = (size_t)(mode == 3 ? tokbase + (row & 127) * 16 + 2 * blk + (row >> 7) : tokbase + (ks0 + row) * d + res); \
            const size_t hk_ = ((size_t)bh * 2048 + (tk - tokbase)) * 64 + sch * 8; kr[jj] = *(const u32x4*)(Kp + hk_); vr[jj] = *(const u32x4*)(Vp + hk_); } \
        _Pragma("unroll") for (int d0 = 0; d0 < NKS; ++d0) qn[d0] = *(const bf16x8*)(Qp + ((size_t)bh * 2048 + (tq - tokbase)) * 64 + d0 * 16 + hi * 8); } while (0)
    DIL_FETCH(0);
    for (int u = 0; u < 24; ++u) {
        DIL_GEOM(u)
#pragma unroll
        for (int jj = 0; jj < 6; ++jj) if (64 * jj < nrows) { const int row = srow + 64 * jj;
            *(LAS u32x4*)(Kl + row * KSTR + sch * 16) = kr[jj];
            *(LAS u32x4*)(Vl + row * 128 + (((sch >> 2) ^ ((row >> 1) & 1)) * 64) + (sch & 3) * 16) = vr[jj]; }
        bf16x8 qf[NKS];
#pragma unroll
        for (int d0 = 0; d0 < NKS; ++d0) qf[d0] = qn[d0];
        __syncthreads();
        if (u + 1 < 24) DIL_FETCH(u + 1);
        const float slope2 = exp2f(-0.5f * (float)(h + 1)) * LOG2E * (float)d;
        const int kbi0 = mode == 3 ? (w & 3) : (qs_w - ks0) >> 5;
        const int nblk = kbi0 + 1 < 5 ? kbi0 + 1 : 5;
        const int rowoff = mode == 3 ? 128 * (w >> 2) : 0;
        float mrun = 0.f, lrun = 0.f; f32x16 o[2]; o[0] = (f32x16){}; o[1] = (f32x16){};
        for (int i = 0; i < nblk; i += 2) {
            const bool hasB = i + 1 < nblk;
            const int kbiA = kbi0 - i, kbiB = hasB ? kbiA - 1 : kbiA;
            const int rbA = rowoff + 32 * kbiA, kbA = ks0 + 32 * kbiA, rbB = rowoff + 32 * kbiB, kbB = ks0 + 32 * kbiB;
            bf16x8 kfA[NKS], kfB[NKS];
            { const LAS unsigned char* kp = Kl + (rbA + r32) * KSTR + hi * 16;
#pragma unroll
              for (int d0 = 0; d0 < NKS; ++d0) kfA[d0] = *(const LAS bf16x8*)(kp + d0 * 32); }
            { const LAS unsigned char* kp = Kl + (rbB + r32) * KSTR + hi * 16;
#pragma unroll
              for (int d0 = 0; d0 < NKS; ++d0) kfB[d0] = *(const LAS bf16x8*)(kp + d0 * 32); }
            f32x16 aA, aB;
#define DIL_INIT(a, kb_) do { const bool inter_ = ((kb_) + 31 <= qs_w) && (qs_w + 31 - (kb_) <= 128); const int base_ = (qs_w + r32) - (kb_) - 4 * hi; const float t0_ = -(slope2 * (float)base_ + mrun); \
              if (inter_) { _Pragma("unroll") for (int r = 0; r < 16; ++r) a[r] = fmaf(slope2, (float)((r & 3) + 8 * (r >> 2)), t0_); } \
              else { _Pragma("unroll") for (int r = 0; r < 16; ++r) { const int delta_ = base_ - ((r & 3) + 8 * (r >> 2)); a[r] = ((unsigned)delta_ <= 128u) ? fmaf(slope2, (float)((r & 3) + 8 * (r >> 2)), t0_) : NEG; } } } while (0)
            DIL_INIT(aA, kbA);
            if (hasB) DIL_INIT(aB, kbB); else {
#pragma unroll
                for (int r = 0; r < 16; ++r) aB[r] = NEG; }
#pragma unroll
            for (int d0 = 0; d0 < NKS; ++d0) {
                aA = __builtin_amdgcn_mfma_f32_32x32x16_bf16(kfA[d0], qf[d0], aA, 0, 0, 0);
                if (hasB) aB = __builtin_amdgcn_mfma_f32_32x32x16_bf16(kfB[d0], qf[d0], aB, 0, 0, 0); }
            s16x4 vlA[2][2], vhA[2][2], vlB[2][2], vhB[2][2];
#pragma unroll
            for (int s = 0; s < 2; ++s) { const LAS unsigned char* vpA = Vl + voff + (rbA + 16 * s) * 128; const LAS unsigned char* vpB = Vl + voff + (rbB + 16 * s) * 128;
#pragma unroll
                for (int db = 0; db < 2; ++db) { vlA[s][db] = vtr(vpA + ((db ^ vsw) * 64)); vhA[s][db] = vtr(vpA + 8 * 128 + ((db ^ vsw) * 64));
                                                 vlB[s][db] = vtr(vpB + ((db ^ vsw) * 64)); vhB[s][db] = vtr(vpB + 8 * 128 + ((db ^ vsw) * 64)); } }
            float mt = NEG;
#pragma unroll
            for (int r = 0; r < 16; ++r) mt = fmaxf(mt, fmaxf(aA[r], aB[r]));
            mt = fmaxf(mt, xhalf(mt));
            if (i == 0 || __any(mt > 0.f)) {
                const float dl = i == 0 ? mt : fmaxf(mt, 0.f);
                const float alpha = i == 0 ? 1.0f : __builtin_amdgcn_exp2f(-dl); mrun += dl; lrun *= alpha;
#pragma unroll
                for (int r = 0; r < 16; ++r) { o[0][r] *= alpha; o[1][r] *= alpha; aA[r] -= dl; aB[r] -= dl; }
            }
            float ls = 0.f;
#pragma unroll
            for (int r = 0; r < 16; ++r) { aA[r] = __builtin_amdgcn_exp2f(aA[r]); ls += aA[r]; }
            if (hasB) {
#pragma unroll
                for (int r = 0; r < 16; ++r) { aB[r] = __builtin_amdgcn_exp2f(aB[r]); ls += aB[r]; } }
            lrun += ls;
#pragma unroll
            for (int s = 0; s < 2; ++s) {
                u32x4 pw; pw.x = cvtpk(aA[8 * s + 0], aA[8 * s + 1]); pw.y = cvtpk(aA[8 * s + 2], aA[8 * s + 3]); pw.z = cvtpk(aA[8 * s + 4], aA[8 * s + 5]); pw.w = cvtpk(aA[8 * s + 6], aA[8 * s + 7]);
                const bf16x8 pf = __builtin_bit_cast(bf16x8, pw);
#pragma unroll
                for (int db = 0; db < 2; ++db) {
                    const bf16x8 vf = (bf16x8){vlA[s][db][0], vlA[s][db][1], vlA[s][db][2], vlA[s][db][3], vhA[s][db][0], vhA[s][db][1], vhA[s][db][2], vhA[s][db][3]};
                    o[db] = __builtin_amdgcn_mfma_f32_32x32x16_bf16(vf, pf, o[db], 0, 0, 0); }
            }
            if (hasB) {
#pragma unroll
                for (int s = 0; s < 2; ++s) {
                    u32x4 pw; pw.x = cvtpk(aB[8 * s + 0], aB[8 * s + 1]); pw.y = cvtpk(aB[8 * s + 2], aB[8 * s + 3]); pw.z = cvtpk(aB[8 * s + 4], aB[8 * s + 5]); pw.w = cvtpk(aB[8 * s + 6], aB[8 * s + 7]);
                    const bf16x8 pf = __builtin_bit_cast(bf16x8, pw);
#pragma unroll
                    for (int db = 0; db < 2; ++db) {
                        const bf16x8 vf = (bf16x8){vlB[s][db][0], vlB[s][db][1], vlB[s][db][2], vlB[s][db][3], vhB[s][db][0], vhB[s][db][1], vhB[s][db][2], vhB[s][db][3]};
                        o[db] = __builtin_amdgcn_mfma_f32_32x32x16_bf16(vf, pf, o[db], 0, 0, 0); }
                } }
        }
#undef DIL_INIT
        const float ltot = lrun + xhalf(lrun); const float inv = 1.0f / ltot;
        store_o_rows<true>(lds + LDS_OST + w * OST_WAVE, o, inv, Opart + (size_t)(mode - 1) * ostride + h * 64, tokbase + qs_w * d + res_w, d, lane);
        if (hi == 0) lse[(size_t)(mode - 1) * M * 16 + (size_t)tq * 16 + h] = mrun + log2f(ltot);
        __syncthreads();
    }
#undef DIL_GEOM
#undef DIL_FETCH
}

struct Args { const float* in[20]; float* out; unsigned char* ws; };

typedef const __attribute__((address_space(4))) Args* KArgsP;
__device__ __forceinline__ KArgsP kargs() { KArgsP p = (KArgsP)__builtin_amdgcn_kernarg_segment_ptr(); asm volatile("" : "+s"(p)); return p; }
#define WSP(T, off) ((T*)(pa->ws + (off)))

__global__ void __launch_bounds__(NTHREADS, 2) yoco_fwd(Args args_unused) {
    extern __shared__ __attribute__((aligned(16))) unsigned char lds_raw[];
    LAS unsigned char* lds = (LAS unsigned char*)lds_raw;
    cg::grid_group grid = cg::this_grid();
#define PHASE_IDS const int tid = pg8::pg8_ltid(), lane = tid & 63; const int wave = __builtin_amdgcn_readfirstlane(tid >> 6); int bid = blockIdx.x; asm volatile("" : "+s"(bid)); \
    const int G = gridDim.x; const int gw = bid * NWAVES + wave, ngw = G * NWAVES; const int gtid = bid * NTHREADS + tid, gthreads = G * NTHREADS; (void)lane; (void)gw; (void)ngw; (void)gtid; (void)gthreads;

    if (threadIdx.x < 2) ((LAS unsigned*)(lds + LDS_MISC))[threadIdx.x] = 0u;
    __syncthreads();
    {
        KArgsP pa = kargs(); PHASE_IDS
        LAS float* scr = (LAS float*)(lds + wave * 16384);
        constexpr int I0 = 16 * 96, I1 = 16 * 32, I2 = 16 * 24, I3 = 4 * 64, I4 = 6 * 48, I5 = 16 * 32, I6 = 16 * 176, I7 = 44 * 32;
        constexpr int NIT = I0 + I1 + I2 + I3 + I4 + I5 + 2 * I6 + 2 * I7;
        for (int it = gw; it < NIT; it += ngw) {
            int r = it;
            if (r < I0) { prep_item<0>(PrepSrc{pa->in[1], nullptr, nullptr, nullptr}, 1024, 3072, WSP(bf16, WS_WQKV), scr, r, lane); continue; } r -= I0;
            if (r < I1) { prep_item<0>(PrepSrc{pa->in[2], nullptr, nullptr, nullptr}, 1024, 1024, WSP(bf16, WS_WOA), scr, r, lane); continue; } r -= I1;
            if (r < I2) { prep_item<1>(PrepSrc{pa->in[3], pa->in[8], pa->in[5], nullptr}, 1024, 768, WSP(bf16, WS_WLAT), scr, r, lane); continue; } r -= I2;
            if (r < I3) { prep_item<2>(PrepSrc{pa->in[6], pa->in[7], nullptr, pa->in[4]}, 256, 2048, WSP(bf16, WS_WUKV), scr, r, lane); continue; } r -= I3;
            if (r < I4) { prep_item<3>(PrepSrc{pa->in[10], nullptr, nullptr, pa->in[9]}, 384, 1536, WSP(bf16, WS_WUQ), scr, r, lane); continue; } r -= I4;
            if (r < I5) { prep_item<0>(PrepSrc{pa->in[11], nullptr, nullptr, nullptr}, 1024, 1024, WSP(bf16, WS_WOB), scr, r, lane); continue; } r -= I5;
            if (r < I6) { prep_item<4>(PrepSrc{pa->in[12], nullptr, nullptr, nullptr}, 1024, 5632, WSP(bf16, WS_WIN0), scr, r, lane); continue; } r -= I6;
            if (r < I6) { prep_item<4>(PrepSrc{pa->in[12] + (size_t)1024 * 5632, nullptr, nullptr, nullptr}, 1024, 5632, WSP(bf16, WS_WIN1), scr, r, lane); continue; } r -= I6;
            if (r < I7) { prep_item<0>(PrepSrc{pa->in[15], nullptr, nullptr, nullptr}, 2816, 1024, WSP(bf16, WS_WOUT0), scr, r, lane); continue; } r -= I7;
            prep_item<0>(PrepSrc{pa->in[15] + (size_t)2816 * 1024, nullptr, nullptr, nullptr}, 2816, 1024, WSP(bf16, WS_WOUT1), scr, r, lane);
        }
        float* rope = WSP(float, WS_ROPE);
        for (int i = gtid; i < SEQ * 16; i += gthreads) {
            const int t = i >> 4, k = i & 15; double f = 1.0; for (int j = 0; j < k; ++j) f *= 0.5623413251903491;
            const float inv_freq = (float)f; const float ang = (float)t * inv_freq;
            const double rev = (double)ang * 0.15915494309189535; const double fr = rev - __builtin_rint(rev);
            rope[2 * i] = __builtin_amdgcn_cosf((float)fr); rope[2 * i + 1] = __builtin_amdgcn_sinf((float)fr);
        }
        if (bid == 0) { unsigned* bw = WSP(unsigned, WS_BAR); for (int i = tid; i < XCD_BAR_WORDS; i += NTHREADS) bw[i] = 0u; }
        { float* rs0 = WSP(float, WS_RS); for (int i = gtid; i < M * 2; i += gthreads) rs0[i] = 0.f; }
        const float* x_in = pa->in[0]; bf16* XB = WSP(bf16, WS_XB);
        for (size_t i = gtid; i < (size_t)M * D / 8; i += gthreads) {
            const f32x4 a = __builtin_nontemporal_load((const f32x4*)x_in + 2 * i), c = __builtin_nontemporal_load((const f32x4*)x_in + 2 * i + 1);
            u32x4 o; o.x = pk2(a[0], a[1]); o.y = pk2(a[2], a[3]); o.z = pk2(c[0], c[1]); o.w = pk2(c[2], c[3]); ((u32x4*)XB)[i] = o; }
    }
    grid.sync();
    (void)xcd_barrier_post((unsigned*)(kargs()->ws + WS_BAR), (volatile LAS unsigned*)(lds + LDS_MISC));

    for (int layer = 0; layer < 2; ++layer) {
        if (layer == 0) {
            { KArgsP pa = kargs(); PHASE_IDS
              pg8::Gemm g{WSP(bf16, WS_XB), WSP(bf16, WS_WQKV), M, 3072, 1024, 1024, 1024}; pg8::StaticOrder S; S.init(M, 3072, G, bid);
              pg8::EpiQKV E{WSP(bf16, WS_R1), (size_t)(WS_R2 - WS_R1) / 2, 0.125f * LOG2E};
              pg8::gemm_phase<pg8::EpiQKV, pg8::StaticOrder, true, true>(lds, g, S, E); }
            GRID_BAR();
            { KArgsP pa = kargs(); PHASE_IDS
              for (int grp = bid; grp < BATCH * NH; grp += G) { const int x = grp & 7, i = grp >> 3;
                  dil_phase(lds, x * 32 + (i >> 3) * 8, i & 7, WSP(bf16, WS_R1), WSP(bf16, WS_R2), WSP(bf16, WS_R3), WSP(bf16, WS_R4), (size_t)(WS_R5 - WS_R4) / 2, WSP(float, WS_LSE)); } }
            GRID_BAR();
            { KArgsP pa = kargs(); PHASE_IDS
              const float* LSE = WSP(float, WS_LSE); const bf16 *R4 = WSP(bf16, WS_R4), *R5 = WSP(bf16, WS_R5), *R6 = WSP(bf16, WS_R6); bf16* R1 = WSP(bf16, WS_R1);
              for (size_t it = gtid; it < (size_t)M * 128; it += gthreads) {
                const size_t tok = it >> 7; const int c8 = (int)(it & 127), hh = c8 >> 3;
                const float l0 = LSE[tok * 16 + hh], l1 = LSE[(size_t)M * 16 + tok * 16 + hh], l2 = LSE[(size_t)2 * M * 16 + tok * 16 + hh];
                const float mx = fmaxf(l0, fmaxf(l1, l2)); float w0 = exp2f(l0 - mx), w1 = exp2f(l1 - mx), w2 = exp2f(l2 - mx); const float inv = 1.0f / (w0 + w1 + w2); w0 *= inv; w1 *= inv; w2 *= inv;
                const u32x4 a = __builtin_nontemporal_load((const u32x4*)(R4 + tok * 1024 + c8 * 8)), bq = __builtin_nontemporal_load((const u32x4*)(R5 + tok * 1024 + c8 * 8)), c = __builtin_nontemporal_load((const u32x4*)(R6 + tok * 1024 + c8 * 8));
                u32x4 o;
                o.x = pk2(w0 * bf_lo(a.x) + w1 * bf_lo(bq.x) + w2 * bf_lo(c.x), w0 * bf_hi(a.x) + w1 * bf_hi(bq.x) + w2 * bf_hi(c.x));
                o.y = pk2(w0 * bf_lo(a.y) + w1 * bf_lo(bq.y) + w2 * bf_lo(c.y), w0 * bf_hi(a.y) + w1 * bf_hi(bq.y) + w2 * bf_hi(c.y));
                o.z = pk2(w0 * bf_lo(a.z) + w1 * bf_lo(bq.z) + w2 * bf_lo(c.z), w0 * bf_hi(a.z) + w1 * bf_hi(bq.z) + w2 * bf_hi(c.z));
                o.w = pk2(w0 * bf_lo(a.w) + w1 * bf_lo(bq.w) + w2 * bf_lo(c.w), w0 * bf_hi(a.w) + w1 * bf_hi(bq.w) + w2 * bf_hi(c.w));
                *(u32x4*)(R1 + tok * 1024 + c8 * 8) = o;
              } }
            GRID_BAR();
        } else {
            { KArgsP pa = kargs(); PHASE_IDS
              pg8::Gemm g{WSP(bf16, WS_XB), WSP(bf16, WS_WLAT), M, NLAT, 1024, 1024, 1024}; pg8::StaticOrder S; S.init(M, NLAT, G, bid);
              pg8::EpiLat E{WSP(bf16, WS_R1), WSP(float, WS_RS), WSP(float, WS_ROPE), WSP(bf16, WS_KR)};
              pg8::gemm_phase<pg8::EpiLat, pg8::StaticOrder, true, true>(lds, g, S, E); }
            GRID_BAR();
            { KArgsP pa = kargs(); PHASE_IDS
              pg8::Gemm g{WSP(bf16, WS_R1), WSP(bf16, WS_WUKV), M, 2048, KVR, NLAT, KVR}; pg8::StaticOrder S; S.init(M, 2048, G, bid);
              pg8::EpiMla E{WSP(bf16, WS_R2), 64, 1024, (size_t)(WS_R3 - WS_R2) / 2, WSP(float, WS_RS), 0, 1.f, WSP(float, WS_ROPE), 0, 1.f / KVR};
              pg8::gemm_phase<pg8::EpiMla, pg8::StaticOrder, true, true>(lds, g, S, E); }
            { KArgsP pa = kargs(); PHASE_IDS
              pg8::Gemm g{WSP(bf16, WS_R1) + 256, WSP(bf16, WS_WUQ), M, NQ, QR, NLAT, QR}; pg8::StaticOrder S; S.init(M, NQ, G, bid);
              pg8::EpiMla E{WSP(bf16, WS_R4), 96, 0, 0, WSP(float, WS_RS), 1, 0.10206207261596577f * LOG2E, WSP(float, WS_ROPE), 1, 1.f / QR};
              pg8::gemm_phase<pg8::EpiMla, pg8::StaticOrder, true, true>(lds, g, S, E); }
            GRID_BAR();
            { KArgsP pa = kargs(); PHASE_IDS
              for (int grp = bid; grp < BATCH * NH; grp += G) { const int x = grp & 7, i = grp >> 3, bhbase = x * 32 + (i >> 2) * 4, mem = i & 3;
                for (int st = 0; st < 4; ++st) { const int bh = bhbase + st;
                  for (int half = 0; half < 2; ++half) { const int qb = half == 0 ? 7 - mem : mem;
                    attn_unit<96>(lds, 0, bh >> 4, bh & 15, qb, WSP(bf16, WS_R4), NQ, (bh & 15) * 96, WSP(bf16, WS_R2), WSP(bf16, WS_KR), WSP(bf16, WS_R3), WSP(bf16, WS_R1), nullptr); } } } }
            GRID_BAR();
        }
        { KArgsP pa = kargs(); PHASE_IDS
          pg8::Gemm g{WSP(bf16, WS_R1), layer == 0 ? WSP(bf16, WS_WOA) : WSP(bf16, WS_WOB), M, 1024, 1024, 1024, 1024}; pg8::StaticOrder S; S.init(M, 1024, G, bid);
          pg8::EpiBf16<0> E{WSP(bf16, WS_R2), 1024, nullptr, 0, 0, 1.f};
          pg8::gemm_phase<pg8::EpiBf16<0>, pg8::StaticOrder, true, true>(lds, g, S, E); }
        GRID_BAR();
        { KArgsP pa = kargs(); PHASE_IDS
          ln_rows(layer == 0 ? pa->in[0] : (const float*)nullptr, WSP(bf16, WS_XB), WSP(bf16, WS_R2), pa->in[16] + layer * D, pa->in[17] + layer * D, (float*)nullptr, WSP(bf16, WS_XB), ((G & 7) == 0 ? ((bid & 7) * (G >> 3) + (bid >> 3)) : bid) * NWAVES + wave, ngw, lane); }
        GRID_BAR();
        { KArgsP pa = kargs(); PHASE_IDS
          pg8::Gemm g{WSP(bf16, WS_XB), layer == 0 ? WSP(bf16, WS_WIN0) : WSP(bf16, WS_WIN1), M, DFF2, 1024, 1024, 1024}; pg8::StaticOrder S; S.init(M, DFF2, G, bid);
          pg8::EpiFfn1 E{WSP(bf16, WS_R1), WSP(bf16, WS_R4), pa->in[13] + (size_t)layer * 3 * DFF2, pa->in[14] + (size_t)layer * DFF2};
          pg8::gemm_phase<pg8::EpiFfn1, pg8::StaticOrder, true, true>(lds, g, S, E); }
        GRID_BAR();
        {
            KArgsP pa = kargs(); PHASE_IDS
            const float* cw = pa->in[13] + (size_t)layer * 3 * DFF2; const float* cb = pa->in[14] + (size_t)layer * DFF2; const bf16* UE = WSP(bf16, WS_R4); bf16* R1 = WSP(bf16, WS_R1);
            for (int it = gtid; it < 512 * 2 * 352; it += gthreads) {
                const int ch = it % 352, rr = (it / 352) & 1, blk = it / 704, f = ch * 8; const bool first = (blk & 31) == 0;
                float cc[2][8];
#pragma unroll
                for (int bj = 0; bj < 2; ++bj) {
                    const u32x4 z = (u32x4){0u, 0u, 0u, 0u};
                    const u32x4 u0 = *(const u32x4*)(UE + ((size_t)(blk * 4 + rr) * 2 + bj) * 2816 + f);
                    const u32x4 u1 = rr == 1 ? *(const u32x4*)(UE + ((size_t)(blk * 4 + 0) * 2 + bj) * 2816 + f) : (first ? z : *(const u32x4*)(UE + ((size_t)((blk - 1) * 4 + 3) * 2 + bj) * 2816 + f));
                    const u32x4 u2 = first ? z : *(const u32x4*)(UE + ((size_t)((blk - 1) * 4 + (rr == 1 ? 3 : 2)) * 2 + bj) * 2816 + f);
                    const float* w0 = cw + bj * 2816 + f; const float* w1 = w0 + 5632; const float* w2 = w1 + 5632; const float* bb = cb + bj * 2816 + f;
#pragma unroll
                    for (int e = 0; e < 4; ++e) {
                        cc[bj][2 * e] = bb[2 * e] + w2[2 * e] * bf_lo(u0[e]) + w1[2 * e] * bf_lo(u1[e]) + w0[2 * e] * bf_lo(u2[e]);
                        cc[bj][2 * e + 1] = bb[2 * e + 1] + w2[2 * e + 1] * bf_hi(u0[e]) + w1[2 * e + 1] * bf_hi(u1[e]) + w0[2 * e + 1] * bf_hi(u2[e]); }
                }
                u32x4 o; o.x = pk2(silu_mul(cc[0][0], cc[1][0]), silu_mul(cc[0][1], cc[1][1])); o.y = pk2(silu_mul(cc[0][2], cc[1][2]), silu_mul(cc[0][3], cc[1][3]));
                o.z = pk2(silu_mul(cc[0][4], cc[1][4]), silu_mul(cc[0][5], cc[1][5])); o.w = pk2(silu_mul(cc[0][6], cc[1][6]), silu_mul(cc[0][7], cc[1][7]));
                *(u32x4*)(R1 + (size_t)(64 * blk + rr) * 2816 + f) = o;
            }
        }
        GRID_BAR();
        { KArgsP pa = kargs(); PHASE_IDS
          pg8::Gemm g{WSP(bf16, WS_R1), layer == 0 ? WSP(bf16, WS_WOUT0) : WSP(bf16, WS_WOUT1), M, 1024, DFF, DFF, DFF}; pg8::StaticOrder S; S.init(M, 1024, G, bid);
          pg8::EpiBf16<0> E{WSP(bf16, WS_R5), 1024, nullptr, 0, 0, 1.f};
          pg8::gemm_phase<pg8::EpiBf16<0>, pg8::StaticOrder, true, true>(lds, g, S, E); }
        GRID_BAR();
        { KArgsP pa = kargs(); PHASE_IDS
          ln_rows((const float*)nullptr, WSP(bf16, WS_XB), WSP(bf16, WS_R5), pa->in[18] + layer * D, pa->in[19] + layer * D, layer == 0 ? (float*)nullptr : pa->out, layer == 0 ? WSP(bf16, WS_XB) : (bf16*)nullptr, ((G & 7) == 0 ? ((bid & 7) * (G >> 3) + (bid >> 3)) : bid) * NWAVES + wave, ngw, lane); }
        if (layer == 0) GRID_BAR();
    }
}

extern "C" void kernel_launch(void* const* d_in, const int* in_sizes, int n_in, void* d_out, int out_size, void* d_ws, size_t ws_size, hipStream_t stream) {
    static int grid = 0;
    if (grid == 0) {
        if (n_in != 20 || in_sizes[0] != M * D || out_size != M * D || ws_size < WS_END) { fprintf(stderr, "kernel_launch: unexpected shapes (n_in %d, in0 %d, out %d, ws %zu); nothing launched\n", n_in, n_in > 0 ? in_sizes[0] : -1, out_size, ws_size); grid = -1; return; }
        int dev = 0, cus = 0, per_cu = 0;
        if (hipGetDevice(&dev) != hipSuccess || hipDeviceGetAttribute(&cus, hipDeviceAttributeMultiprocessorCount, dev) != hipSuccess) { fprintf(stderr, "kernel_launch: device query failed\n"); grid = -1; return; }
        if (hipFuncSetAttribute((const void*)yoco_fwd, hipFuncAttributeMaxDynamicSharedMemorySize, LDS_BYTES) != hipSuccess) { fprintf(stderr, "kernel_launch: hipFuncSetAttribute failed\n"); grid = -1; return; }
        if (hipOccupancyMaxActiveBlocksPerMultiprocessor(&per_cu, (const void*)yoco_fwd, NTHREADS, LDS_BYTES) != hipSuccess || per_cu < 1) { fprintf(stderr, "kernel_launch: occupancy query says %d blocks per CU\n", per_cu); (void)hipGetLastError(); per_cu = 1; }
        grid = cus * 1;
    }
    if (grid < 0) return;
    Args a{};
    for (int i = 0; i < 20; ++i) a.in[i] = (const float*)d_in[i];
    a.out = (float*)d_out; a.ws = (unsigned char*)d_ws;
    void* kargs[] = {&a};
    const hipError_t e = hipLaunchCooperativeKernel((const void*)yoco_fwd, dim3(grid), dim3(NTHREADS), kargs, LDS_BYTES, stream);
    if (e != hipSuccess) fprintf(stderr, "kernel_launch: cooperative launch failed: %s (grid %d)\n", hipGetErrorString(e), grid);
}
```

```cpp
#include <hip/hip_runtime.h>
#include <hip/hip_cooperative_groups.h>
#include <cstdio>
#include <cstdint>
#include <cmath>
namespace cg = cooperative_groups;
namespace pg8 {
#define PG8_LAS __attribute__((address_space(3)))
typedef unsigned short bf16_t;
typedef short bf16x8 __attribute__((ext_vector_type(8)));
typedef float f32x4 __attribute__((ext_vector_type(4)));
typedef unsigned u32x4 __attribute__((ext_vector_type(4)));
constexpr int BM = 256, BK = 64, HALF = 128, HTB = HALF * BK * 2  , STAGE_BYTES = 8 * HTB, NXCD = 8, WGM = 8;

__host__ __device__ __forceinline__ int lds_byte(int r, int c) { const int st = (r >> 4) * 2 + (c >> 5), rr = r & 15, cc = c & 31, ob = rr * 64 + cc * 2; return st * 1024 + (ob ^ (((ob >> 9) & 1) << 5)); }
__host__ __device__ __forceinline__ void stage_rc(int b, int& R, int& C) { const int st = b / 1024, sb = b % 1024, swz = sb ^ (((sb >> 9) & 1) << 5); R = (st >> 1) * 16 + swz / 64; C = (st & 1) * 32 + (swz % 64) / 2; }
__host__ __device__ __forceinline__ int perm32(int rho) { const int n = rho >> 4, i = rho & 15; return 8 * (i >> 2) + 4 * n + (i & 3); }

__device__ __forceinline__ int pg8_ltid() { int t = threadIdx.x; asm volatile("" : "+v"(t)); return t; }
struct Unit { int pm, pn; };
struct Gemm { const bf16_t* A; const bf16_t* Bt; int M, N, K, lda, ldb; };

struct StaticOrder {
    int nM, nN, nwg, G, c;
    __host__ __device__ void init(int M, int N, int G_, int c_) { nM = M / BM; nN = N / BM; nwg = nM * nN; G = G_; c = c_; }
    __host__ __device__ bool next(int i, Unit& u) const {
        const long L = (long)i * G + c; if (L >= nwg) return false;
        int wgid = (int)L; { const int q = nwg / NXCD, r = nwg % NXCD, xcd = wgid % NXCD, off = wgid / NXCD; wgid = (xcd < r ? xcd * (q + 1) : r * (q + 1) + (xcd - r) * q) + off; }
        const int nig = WGM * nN, gid = wgid / nig, fm = gid * WGM, gsz = (nM - fm) < WGM ? (nM - fm) : WGM;
        u.pm = fm + ((wgid % nig) % gsz); u.pn = (wgid % nig) / gsz; return true;
    }
    __device__ __forceinline__ void a_ready(const Unit&) const {}
    __device__ __forceinline__ void done(const Unit&) const {}
};

__device__ __forceinline__ unsigned cvt_pk_bf16(float lo, float hi) { unsigned r; asm volatile("v_cvt_pk_bf16_f32 %0, %1, %2" : "=v"(r) : "v"(lo), "v"(hi)); return r; }
typedef float f32x2 __attribute__((ext_vector_type(2)));
__device__ __forceinline__ f32x2 gelu_pk(f32x2 v) {
    const f32x2 av = __builtin_elementwise_abs(v), d = av * 0.2316418882f + 1.0f;
    f32x2 t; t.x = __builtin_amdgcn_rcpf(d.x); t.y = __builtin_amdgcn_rcpf(d.y);
    f32x2 q = t * 0.5307027145f + (-0.7265760135f); q = q * t + 0.7107068705f; q = q * t + (-0.142248368f); q = q * t + 0.127414796f; q = q * t;
    const f32x2 s = (v * v) * (-0.72134752044f);
    f32x2 e; e.x = __builtin_amdgcn_exp2f(s.x); e.y = __builtin_amdgcn_exp2f(s.y);
    const f32x2 m = v * (q * e), r = v - m;
    f32x2 o; o.x = v.x < 0.f ? m.x : r.x; o.y = v.y < 0.f ? m.y : r.y; return o;
}

template <int ACT  > struct EpiBf16 {
    static constexpr bool PERM = true, AFTER_DRAIN = false; static_assert(ACT == 0 || ACT == 1, "EpiBf16: ACT is 0 (none) or 1 (gelu_pk)");
    bf16_t* O; int ldc; const float* bias; int split_cols; size_t split_stride; float scale0;
    __device__ __forceinline__ void operator()(const f32x4 (&acc)[2][2][4][2], const Unit& u, int wr, int wc, int fr, int fq) const {
        const int row0 = u.pm * BM + wr * 64 + fr; int colt = u.pn * BM; bf16_t* base = O;
        float sc = 1.f; if (split_cols) { const int t = colt / split_cols; base += (size_t)t * split_stride; colt -= t * split_cols; if (t == 0) sc = scale0; }
        const int col0 = colt + wc * 32 + 8 * fq, bcol0 = u.pn * BM + wc * 32 + 8 * fq;
        f32x4 bv[2][2];
#pragma unroll
        for (int bj = 0; bj < 2; ++bj)
#pragma unroll
            for (int n = 0; n < 2; ++n) bv[bj][n] = bias ? *(const f32x4*)(bias + bcol0 + bj * HALF + 4 * n) : (f32x4){0.f, 0.f, 0.f, 0.f};
#pragma unroll
        for (int ai = 0; ai < 2; ++ai)
#pragma unroll
            for (int m = 0; m < 4; ++m) { bf16_t* rowp = base + (size_t)(row0 + ai * HALF + m * 16) * ldc + col0;
#pragma unroll
                for (int bj = 0; bj < 2; ++bj) { f32x4 v0 = acc[ai][bj][m][0] + bv[bj][0], v1 = acc[ai][bj][m][1] + bv[bj][1];
                    if (ACT == 1) { f32x2 a = gelu_pk((f32x2){v0[0], v0[1]}), b = gelu_pk((f32x2){v0[2], v0[3]}), c = gelu_pk((f32x2){v1[0], v1[1]}), d = gelu_pk((f32x2){v1[2], v1[3]});
                        v0 = (f32x4){a.x, a.y, b.x, b.y}; v1 = (f32x4){c.x, c.y, d.x, d.y}; }
                    v0 = v0 * sc; v1 = v1 * sc; u32x4 w; w.x = cvt_pk_bf16(v0[0], v0[1]); w.y = cvt_pk_bf16(v0[2], v0[3]); w.z = cvt_pk_bf16(v1[0], v1[1]); w.w = cvt_pk_bf16(v1[2], v1[3]);
                    *(u32x4*)(rowp + bj * HALF) = w; } }
    }
};
typedef unsigned u32x2 __attribute__((ext_vector_type(2)));
struct EpiMla {
    static constexpr bool PERM = true, AFTER_DRAIN = false;
    bf16_t* O; int ldc; int split_cols; size_t split_stride; const float* rs; int rsi; float cscale; const float* rope; int qmode; float invk;
    __device__ __forceinline__ void operator()(const f32x4 (&acc)[2][2][4][2], const Unit& u, int wr, int wc, int fr, int fq) const {
        const int row0 = u.pm * BM + wr * 64 + fr; int colt = u.pn * BM; bf16_t* base = O;
        if (split_cols) { const int t = colt / split_cols; base += (size_t)t * split_stride; colt -= t * split_cols; }
        const int col0 = colt + wc * 32 + 8 * fq;
#pragma unroll
        for (int ai = 0; ai < 2; ++ai)
#pragma unroll
            for (int m = 0; m < 4; ++m) { const int row = row0 + ai * HALF + m * 16; const float s = __builtin_amdgcn_rsqf(rs[row * 2 + rsi] * invk + 1e-6f) * cscale; const int bb_ = row >> 11, tok_ = row & 2047;
#pragma unroll
                for (int bj = 0; bj < 2; ++bj) { f32x4 v0 = acc[ai][bj][m][0] * s, v1 = acc[ai][bj][m][1] * s;
                    if (qmode) { const int o = (col0 + bj * HALF) % 96;
                        if (o >= 64) { const int i0 = (o - 64) >> 1; const int t = row & 2047; const f32x4* tb = (const f32x4*)(rope + ((size_t)t * 16 + i0) * 2); const f32x4 c0 = tb[0], c1 = tb[1];
                            float a, b;
                            a = v0[0]; b = v0[1]; v0[0] = a * c0[0] - b * c0[1]; v0[1] = b * c0[0] + a * c0[1];
                            a = v0[2]; b = v0[3]; v0[2] = a * c0[2] - b * c0[3]; v0[3] = b * c0[2] + a * c0[3];
                            a = v1[0]; b = v1[1]; v1[0] = a * c1[0] - b * c1[1]; v1[1] = b * c1[0] + a * c1[1];
                            a = v1[2]; b = v1[3]; v1[2] = a * c1[2] - b * c1[3]; v1[3] = b * c1[2] + a * c1[3]; } }
                    u32x4 w; w.x = cvt_pk_bf16(v0[0], v0[1]); w.y = cvt_pk_bf16(v0[2], v0[3]); w.z = cvt_pk_bf16(v1[0], v1[1]); w.w = cvt_pk_bf16(v1[2], v1[3]);
                    { const int col = col0 + bj * HALF; const int hh_ = col / ldc, dd_ = col - hh_ * ldc; *(u32x4*)(base + ((size_t)(bb_ * 16 + hh_) * 2048 + tok_) * ldc + dd_) = w; } } }
    }
};
struct EpiQKV {
    static constexpr bool PERM = true, AFTER_DRAIN = false;
    bf16_t* O; size_t t_stride; float scale0;
    __device__ __forceinline__ void operator()(const f32x4 (&acc)[2][2][4][2], const Unit& u, int wr, int wc, int fr, int fq) const {
        const int row0 = u.pm * BM + wr * 64 + fr; const int colt = u.pn * BM; const int t = colt >> 10; bf16_t* base = O + (size_t)t * t_stride; const float sc = t == 0 ? scale0 : 1.f;
        const int cc0 = (colt & 1023) + wc * 32 + 8 * fq;
#pragma unroll
        for (int ai = 0; ai < 2; ++ai)
#pragma unroll
            for (int m = 0; m < 4; ++m) { const int row = row0 + ai * HALF + m * 16; const int bb_ = row >> 11, tok_ = row & 2047;
#pragma unroll
                for (int bj = 0; bj < 2; ++bj) { const int cc = cc0 + bj * HALF; const int hh_ = cc >> 6, dd_ = cc & 63;
                    const f32x4 v0 = acc[ai][bj][m][0] * sc, v1 = acc[ai][bj][m][1] * sc;
                    u32x4 w; w.x = cvt_pk_bf16(v0[0], v0[1]); w.y = cvt_pk_bf16(v0[2], v0[3]); w.z = cvt_pk_bf16(v1[0], v1[1]); w.w = cvt_pk_bf16(v1[2], v1[3]);
                    *(u32x4*)(base + ((size_t)(bb_ * 16 + hh_) * 2048 + tok_) * 64 + dd_) = w; } }
    }
};
struct EpiLat {
    static constexpr bool PERM = true, AFTER_DRAIN = false;
    bf16_t* O; float* ss; const float* rope; bf16_t* KR;
    __device__ __forceinline__ void operator()(const f32x4 (&acc)[2][2][4][2], const Unit& u, int wr, int wc, int fr, int fq) const {
        const int row0 = u.pm * BM + wr * 64 + fr; const int col0 = u.pn * BM + wc * 32 + 8 * fq;
#pragma unroll
        for (int ai = 0; ai < 2; ++ai)
#pragma unroll
            for (int m = 0; m < 4; ++m) { const int row = row0 + ai * HALF + m * 16; bf16_t* rowp = O + (size_t)row * 768 + col0; float sq = 0.f;
#pragma unroll
                for (int bj = 0; bj < 2; ++bj) { const f32x4 v0 = acc[ai][bj][m][0], v1 = acc[ai][bj][m][1];
                    u32x4 w; w.x = cvt_pk_bf16(v0[0], v0[1]); w.y = cvt_pk_bf16(v0[2], v0[3]); w.z = cvt_pk_bf16(v1[0], v1[1]); w.w = cvt_pk_bf16(v1[2], v1[3]);
                    *(u32x4*)(rowp + bj * HALF) = w;
                    if (u.pn < 2 || bj == 0) sq += (v0[0] * v0[0] + v0[1] * v0[1]) + (v0[2] * v0[2] + v0[3] * v0[3]) + (v1[0] * v1[0] + v1[1] * v1[1]) + (v1[2] * v1[2] + v1[3] * v1[3]);
                    else if (wc == 0) {
                        const int t = row & 2047; const f32x4* tb = (const f32x4*)(rope + ((size_t)t * 16 + 4 * fq) * 2); const f32x4 c0 = tb[0], c1 = tb[1];
                        u32x4 k; k.x = cvt_pk_bf16(v0[0] * c0[0] - v0[1] * c0[1], v0[1] * c0[0] + v0[0] * c0[1]); k.y = cvt_pk_bf16(v0[2] * c0[2] - v0[3] * c0[3], v0[3] * c0[2] + v0[2] * c0[3]);
                        k.z = cvt_pk_bf16(v1[0] * c1[0] - v1[1] * c1[1], v1[1] * c1[0] + v1[0] * c1[1]); k.w = cvt_pk_bf16(v1[2] * c1[2] - v1[3] * c1[3], v1[3] * c1[2] + v1[2] * c1[3]);
                        *(u32x4*)(KR + (size_t)row * 32 + 8 * fq) = k; } }
                sq += __shfl_xor(sq, 16); sq += __shfl_xor(sq, 32);
                if (fq == 0) atomicAdd(ss + row * 2 + (u.pn == 0 ? 0 : 1), sq); }
    }
};
struct EpiFfn1 {
    static constexpr bool PERM = true, AFTER_DRAIN = false;
    bf16_t* H; bf16_t* UE; const float* cw; const float* cb;
    __device__ __forceinline__ void operator()(const f32x4 (&acc)[2][2][4][2], const Unit& u, int wr, int wc, int fr, int fq) const {
        const int f0 = u.pn * 128 + wc * 32 + 8 * fq;
        u32x2 hold[8];
#pragma unroll
        for (int n = 0; n < 2; ++n) {
            const int f = f0 + 4 * n;
            f32x4 w[2][3], bb[2];
#pragma unroll
            for (int bj = 0; bj < 2; ++bj) {
#pragma unroll
                for (int j = 0; j < 3; ++j) w[bj][j] = *(const f32x4*)(cw + j * 5632 + bj * 2816 + f);
                bb[bj] = *(const f32x4*)(cb + bj * 2816 + f); }
#pragma unroll
            for (int ai = 0; ai < 2; ++ai) {
                const int blk = 4 * u.pm + 2 * ai + wr;
#pragma unroll
                for (int m = 0; m < 4; ++m) {
                    f32x4 c[2];
#pragma unroll
                    for (int bj = 0; bj < 2; ++bj) {
                        const f32x4 X = acc[ai][bj][m][n]; f32x4 p1, p2;
#pragma unroll
                        for (int e = 0; e < 4; ++e) {
                            const float xe = X[e]; const int xi = __builtin_bit_cast(int, xe);
                            int b1 = 0, b2 = 0;
                            if (m > 0) { const float pe = acc[ai][bj][m > 0 ? m - 1 : 0][n][e]; const int pi = __builtin_bit_cast(int, pe);
                                b1 = __builtin_amdgcn_update_dpp(0, pi, 0x10F, 0xf, 0xf, true); b2 = __builtin_amdgcn_update_dpp(0, pi, 0x10E, 0xf, 0xf, true); }
                            p1[e] = __builtin_bit_cast(float, __builtin_amdgcn_update_dpp(b1, xi, 0x111, 0xf, 0xf, false));
                            p2[e] = __builtin_bit_cast(float, __builtin_amdgcn_update_dpp(b2, xi, 0x112, 0xf, 0xf, false)); }
                        c[bj] = bb[bj] + w[bj][2] * X + w[bj][1] * p1 + w[bj][0] * p2;
                        if (m == 0 && fr < 2) { u32x2 t; t.x = cvt_pk_bf16(X[0], X[1]); t.y = cvt_pk_bf16(X[2], X[3]); *(u32x2*)(UE + ((size_t)(blk * 4 + fr) * 2 + bj) * 2816 + f) = t; }
                        if (m == 3 && fr >= 14) { u32x2 t; t.x = cvt_pk_bf16(X[0], X[1]); t.y = cvt_pk_bf16(X[2], X[3]); *(u32x2*)(UE + ((size_t)(blk * 4 + 2 + (fr - 14)) * 2 + bj) * 2816 + f) = t; }
                    }
                    f32x4 hv;
#pragma unroll
                    for (int e = 0; e < 4; ++e) { const float g = c[0][e]; hv[e] = g * __builtin_amdgcn_rcpf(1.0f + __expf(-g)) * c[1][e]; }
                    const int row = u.pm * BM + ai * HALF + wr * 64 + m * 16 + fr;
                    u32x2 t; t.x = cvt_pk_bf16(hv[0], hv[1]); t.y = cvt_pk_bf16(hv[2], hv[3]);
                    if (n == 0) hold[ai * 4 + m] = t;
                    else { u32x4 w4; w4.x = hold[ai * 4 + m].x; w4.y = hold[ai * 4 + m].y; w4.z = t.x; w4.w = t.y; *(u32x4*)(H + (size_t)row * 2816 + f0) = w4; }
                }
            }
        }
    }
};
template <class Epi, class Sched, bool ALIGN_EPI = false, bool SP2 = false>
__device__ __forceinline__ void gemm_phase(PG8_LAS unsigned char* lds, const Gemm g, const Sched& S, const Epi& E) {
    const int tid = pg8_ltid(), wid = __builtin_amdgcn_readfirstlane(tid >> 6), lane = tid & 63, wr = wid >> 2, wc = wid & 3, fr = lane & 15, fq = lane >> 4;
    const int K = g.K, nt = K / BK;
    unsigned voffA[2], voffB[2];
#pragma unroll
    for (int i = 0; i < 2; ++i) { int R, C; stage_rc(tid * 16 + i * 8192, R, C); const int Rb = Epi::PERM ? ((R & ~31) + perm32(R & 31)) : R;
        voffA[i] = (unsigned)(R * g.lda + C) * 2u; voffB[i] = (unsigned)(Rb * g.ldb + C) * 2u; }
    const size_t kstep = (size_t)(BK * 2);
    const size_t hstepA = (size_t)HALF * g.lda * 2, hstepB = (size_t)HALF * g.ldb * 2;
    const size_t tstepA = 2 * hstepA, tstepB = 2 * hstepB;
    const unsigned ldsw = (unsigned)wid * 1024u;
    const int aoff = lds_byte(wr * 64 + fr, fq * 8), boff = lds_byte(wc * 32 + fr, fq * 8);
#define PG8_SA(b, h) (((b) * 2 + (h)) * HTB)
#define PG8_SB(b, h) ((4 + (b) * 2 + (h)) * HTB)
#define PG8_STAGE(bufoff, gbase, voff) do { _Pragma("unroll") for (int _i = 0; _i < 2; ++_i) \
        __builtin_amdgcn_global_load_lds((const unsigned*)((const char*)(gbase) + (voff)[_i]), (PG8_LAS unsigned*)(lds + (bufoff) + ldsw + _i * 8192), 16, 0, 0); } while (0)
#define PG8_LDA(dst, b, h) do { _Pragma("unroll") for (int m = 0; m < 4; ++m) _Pragma("unroll") for (int k = 0; k < 2; ++k) dst[m][k] = *(const PG8_LAS bf16x8*)(lds + PG8_SA(b, h) + aoff + m * 2048 + k * 1024); } while (0)
#define PG8_LDB(dst, b, h) do { _Pragma("unroll") for (int n = 0; n < 2; ++n) _Pragma("unroll") for (int k = 0; k < 2; ++k) dst[n][k] = *(const PG8_LAS bf16x8*)(lds + PG8_SB(b, h) + boff + n * 2048 + k * 1024); } while (0)
#define PG8_MMA(ai, bj, At, Bt) do { __builtin_amdgcn_s_setprio(1); _Pragma("unroll") for (int m = 0; m < 4; ++m) _Pragma("unroll") for (int n = 0; n < 2; ++n) _Pragma("unroll") for (int k = 0; k < 2; ++k) \
        acc[ai][bj][m][n] = __builtin_amdgcn_mfma_f32_16x16x32_bf16(Bt[n][k], At[m][k], acc[ai][bj][m][n], 0, 0, 0); __builtin_amdgcn_s_setprio(0); } while (0)
#define PG8_WAIT_V(n) asm volatile("s_waitcnt vmcnt(" #n ")" ::: "memory")
#define PG8_WAIT_L(n) asm volatile("s_waitcnt lgkmcnt(" #n ")" ::: "memory")
#define PG8_BAR __builtin_amdgcn_s_barrier()
#define PG8_SCHED __builtin_amdgcn_sched_barrier(0)
    Unit cur, nxt; int ui = 0;
    if (!S.next(0, cur)) return;
    f32x4 acc[2][2][4][2];
#pragma unroll
    for (int a = 0; a < 2; ++a)
#pragma unroll
        for (int b = 0; b < 2; ++b)
#pragma unroll
            for (int m = 0; m < 4; ++m)
#pragma unroll
                for (int n = 0; n < 2; ++n) acc[a][b][m][n] = (f32x4){0.f, 0.f, 0.f, 0.f};
    bf16x8 At[4][2], B0[2][2], B1[2][2];
    const char* cA = (const char*)g.A + (size_t)cur.pm * tstepA; const char* cB = (const char*)g.Bt + (size_t)cur.pn * tstepB;
    S.a_ready(cur);
    if constexpr (SP2) {
        PG8_STAGE(PG8_SB(0, 0), cB, voffB); PG8_STAGE(PG8_SB(0, 1), cB + hstepB, voffB); PG8_STAGE(PG8_SA(0, 0), cA, voffA); PG8_STAGE(PG8_SA(0, 1), cA + hstepA, voffA);
        if (wr == 1) PG8_BAR;
        PG8_WAIT_V(2); PG8_BAR;
        PG8_STAGE(PG8_SB(1, 0), cB + kstep, voffB); PG8_STAGE(PG8_SA(1, 0), cA + kstep, voffA); PG8_STAGE(PG8_SB(1, 1), cB + hstepB + kstep, voffB);
        PG8_WAIT_V(6); PG8_BAR;
    } else {
        PG8_STAGE(PG8_SB(0, 0), cB, voffB); PG8_STAGE(PG8_SA(0, 0), cA, voffA); PG8_STAGE(PG8_SB(0, 1), cB + hstepB, voffB); PG8_STAGE(PG8_SA(0, 1), cA + hstepA, voffA);
        if (wr == 1) PG8_BAR;
        PG8_WAIT_V(4); PG8_BAR;
        PG8_STAGE(PG8_SB(1, 0), cB + kstep, voffB); PG8_STAGE(PG8_SA(1, 0), cA + kstep, voffA); PG8_STAGE(PG8_SB(1, 1), cB + hstepB + kstep, voffB);
        PG8_WAIT_V(6); PG8_BAR;
    }
    for (;;) {
        const bool has_next = S.next(ui + 1, nxt);
        const char* nA = has_next ? (const char*)g.A + (size_t)nxt.pm * tstepA : cA; const char* nB = has_next ? (const char*)g.Bt + (size_t)nxt.pn * tstepB : cB;
        for (int t = 0; t < nt; t += 2) {
            const bool last = (t == nt - 2);
            const char* a1 = cA + (size_t)(t + 1) * kstep;
            const char* a2 = last ? nA : cA + (size_t)(t + 2) * kstep; const char* b2 = last ? nB : cB + (size_t)(t + 2) * kstep;
            const char* a3 = a2 + kstep; const char* b3 = b2 + kstep;
            if (last && has_next) S.a_ready(nxt);
            if constexpr (SP2) {
            PG8_LDB(B0, 0, 0); PG8_LDB(B1, 0, 1); PG8_SCHED; PG8_LDA(At, 0, 0); PG8_STAGE(PG8_SA(1, 1), a1 + hstepA, voffA);
            PG8_WAIT_V(8); PG8_WAIT_L(0); PG8_BAR; PG8_MMA(0, 0, At, B0); PG8_MMA(0, 1, At, B1); PG8_BAR; PG8_SCHED;
            PG8_LDA(At, 0, 1); PG8_STAGE(PG8_SB(0, 0), b2, voffB); PG8_STAGE(PG8_SB(0, 1), b2 + hstepB, voffB); PG8_STAGE(PG8_SA(0, 0), a2, voffA);
            PG8_WAIT_V(8); PG8_WAIT_L(0); PG8_BAR; PG8_MMA(1, 0, At, B0); PG8_MMA(1, 1, At, B1); PG8_BAR; PG8_SCHED;
            PG8_LDB(B0, 1, 0); PG8_LDB(B1, 1, 1); PG8_SCHED; PG8_LDA(At, 1, 0); PG8_STAGE(PG8_SA(0, 1), a2 + hstepA, voffA);
            PG8_WAIT_V(8); PG8_WAIT_L(0); PG8_BAR; PG8_MMA(0, 0, At, B0); PG8_MMA(0, 1, At, B1); PG8_BAR; PG8_SCHED;
            PG8_LDA(At, 1, 1); PG8_STAGE(PG8_SB(1, 0), b3, voffB); PG8_STAGE(PG8_SB(1, 1), b3 + hstepB, voffB); PG8_STAGE(PG8_SA(1, 0), a3, voffA);
            PG8_WAIT_V(8); PG8_WAIT_L(0); PG8_BAR; PG8_MMA(1, 0, At, B0); PG8_MMA(1, 1, At, B1); PG8_BAR; PG8_SCHED;
            } else {
            PG8_LDB(B0, 0, 0); PG8_SCHED; PG8_LDA(At, 0, 0); PG8_STAGE(PG8_SA(1, 1), a1 + hstepA, voffA);
            PG8_WAIT_L(8); PG8_BAR; PG8_WAIT_L(0); PG8_MMA(0, 0, At, B0); PG8_BAR; PG8_SCHED;
            PG8_LDB(B1, 0, 1); PG8_STAGE(PG8_SB(0, 0), b2, voffB);
            PG8_BAR; PG8_WAIT_L(0); PG8_MMA(0, 1, At, B1); PG8_BAR;
            PG8_LDA(At, 0, 1); PG8_STAGE(PG8_SA(0, 0), a2, voffA);
            PG8_BAR; PG8_WAIT_L(0); PG8_MMA(1, 0, At, B0); PG8_BAR; PG8_SCHED;
            PG8_STAGE(PG8_SB(0, 1), b2 + hstepB, voffB);
            PG8_WAIT_V(6); PG8_BAR; PG8_MMA(1, 1, At, B1); PG8_BAR;
            PG8_LDB(B0, 1, 0); PG8_SCHED; PG8_LDA(At, 1, 0); PG8_STAGE(PG8_SA(0, 1), a2 + hstepA, voffA);
            PG8_WAIT_L(8); PG8_BAR; PG8_WAIT_L(0); PG8_MMA(0, 0, At, B0); PG8_BAR; PG8_SCHED;
            PG8_LDB(B1, 1, 1); PG8_STAGE(PG8_SB(1, 0), b3, voffB);
            PG8_BAR; PG8_WAIT_L(0); PG8_MMA(0, 1, At, B1); PG8_BAR;
            PG8_LDA(At, 1, 1); PG8_STAGE(PG8_SA(1, 0), a3, voffA);
            PG8_BAR; PG8_WAIT_L(0); PG8_MMA(1, 0, At, B0); PG8_BAR; PG8_SCHED;
            PG8_STAGE(PG8_SB(1, 1), b3 + hstepB, voffB);
            PG8_WAIT_V(6); PG8_BAR; PG8_MMA(1, 1, At, B1); PG8_BAR;
            }
        }
        if constexpr (ALIGN_EPI) { if (wr == 0) PG8_BAR; }
        if constexpr (!Epi::AFTER_DRAIN) { E(acc, cur, wr, wc, fr, fq); S.done(cur); }
        if (!has_next) break;
#pragma unroll
        for (int a = 0; a < 2; ++a)
#pragma unroll
            for (int b = 0; b < 2; ++b)
#pragma unroll
                for (int m = 0; m < 4; ++m)
#pragma unroll
                    for (int n = 0; n < 2; ++n) acc[a][b][m][n] = (f32x4){0.f, 0.f, 0.f, 0.f};
        cur = nxt; cA = nA; cB = nB; ++ui;
        if constexpr (ALIGN_EPI) { if (wr == 1) PG8_BAR; }
    }
    PG8_WAIT_V(0);
    if constexpr (!ALIGN_EPI) { if (wr == 0) PG8_BAR; }
    PG8_BAR;
    if constexpr (Epi::AFTER_DRAIN) { E.fused(acc, cur, wr, wc, fr, fq, lds, wid, lane); S.done(cur); }
#undef PG8_SA
#undef PG8_SB
#undef PG8_STAGE
#undef PG8_LDA
#undef PG8_LDB
#undef PG8_MMA
#undef PG8_WAIT_V
#undef PG8_WAIT_L
#undef PG8_BAR
#undef PG8_SCHED
}
}
#define LAS __attribute__((address_space(3)))
typedef unsigned short bf16;
typedef short bf16x8 __attribute__((ext_vector_type(8)));
typedef float f32x4 __attribute__((ext_vector_type(4)));
typedef float f32x16 __attribute__((ext_vector_type(16)));
typedef unsigned u32x4 __attribute__((ext_vector_type(4)));
typedef unsigned u32x2 __attribute__((ext_vector_type(2)));
typedef short v4i16_t __attribute__((ext_vector_type(4)));
constexpr int NWAVES = 8, NTHREADS = 512;
constexpr int SEQ = 2048, BATCH = 16, M = BATCH * SEQ, D = 1024, NH = 16, DFF = 2816, DFF2 = 5632;
constexpr int NLAT = 768, KVR = 256, QR = 384, NQ = 1536;
constexpr float ALPHA = 1.4142135623730951f;
constexpr float LN_EPS = 1e-5f, RMS_EPS = 1e-6f;
constexpr float LOG2E = 1.4426950408889634f;
constexpr size_t MiB = 1u << 20;
constexpr size_t WS_ROPE = 1 * MiB;
constexpr size_t WS_WQKV = 2 * MiB, WS_WOA = 8 * MiB, WS_WLAT = 10 * MiB, WS_WUKV = 12 * MiB, WS_WUQ = 13 * MiB, WS_WOB = 15 * MiB;
constexpr size_t WS_WIN0 = 17 * MiB, WS_WIN1 = 28 * MiB, WS_WOUT0 = 39 * MiB, WS_WOUT1 = 39 * MiB + 5632 * 1024, WS_WEND = 50 * MiB;
constexpr size_t WS_RS = 52 * MiB;
constexpr size_t WS_KR = 53 * MiB;
constexpr size_t WS_LSE = 56 * MiB;
constexpr size_t WS_XB = 62 * MiB;
constexpr size_t WS_SP = 64 * MiB + 272 * 1024;
constexpr size_t WS_R1 = WS_XB + WS_SP, WS_R2 = WS_R1 + WS_SP, WS_R3 = WS_R2 + WS_SP, WS_R4 = WS_R3 + WS_SP, WS_R5 = WS_R4 + WS_SP, WS_R6 = WS_R5 + WS_SP, WS_END = 512 * MiB;
static_assert(WS_R6 + 64 * MiB <= WS_END && WS_R1 + (size_t)32768 * 2816 * 2 <= WS_R4 && WS_R4 + (size_t)32768 * 1536 * 2 <= WS_R6 + 64 * MiB, "d_ws map");
constexpr int LDS_OST = 104448, OST_WAVE = 32 * 144;
constexpr int LDS_MISC = LDS_OST + 8 * OST_WAVE;
constexpr int LDS_BYTES = LDS_MISC + 2048;

__device__ __forceinline__ unsigned f2bf(float f) { unsigned u = __builtin_bit_cast(unsigned, f); return (u + 0x7fffu + ((u >> 16) & 1u)) >> 16; }
__device__ __forceinline__ unsigned pk2(float lo, float hi) { return f2bf(lo) | (f2bf(hi) << 16); }
__device__ __forceinline__ float bf_lo(unsigned w) { return __builtin_bit_cast(float, w << 16); }
__device__ __forceinline__ float bf_hi(unsigned w) { return __builtin_bit_cast(float, w & 0xffff0000u); }
__device__ __forceinline__ float wave_sum(float v) {
#pragma unroll
    for (int o = 1; o < 64; o <<= 1) v += __shfl_xor(v, o);
    return v;
}
__device__ __forceinline__ float silu_mul(float g, float v) { return g * __builtin_amdgcn_rcpf(1.0f + __expf(-g)) * v; }

#define GAS __attribute__((address_space(1)))
typedef GAS unsigned gu32;
typedef GAS unsigned long long gu64;
#define RLX_AGENT __ATOMIC_RELAXED, __HIP_MEMORY_SCOPE_AGENT
#define LDS_WAIT() asm volatile("s_waitcnt lgkmcnt(0)" ::: "memory")
#define VM_WAIT() asm volatile("s_waitcnt vmcnt(0)" ::: "memory")
#define XB_TMO      128
#define XB_XCNT(j)  (256  + 64 * (j))
#define XB_XSUB(j)  (1280 + 64 * (j))
#define XB_XGEN(j)  (2304 + 64 * (j))
#define XB_TOP      3328
#define XB_TOPGEN   3392
#define XCD_BAR_WORDS 3456
#define XB_SPIN_CAP (1u << 18)

__device__ __forceinline__ unsigned xb_ld(unsigned* p)              { return __hip_atomic_load(p, __ATOMIC_RELAXED, __HIP_MEMORY_SCOPE_AGENT); }
__device__ __forceinline__ unsigned xb_add(unsigned* p, unsigned v) { return __hip_atomic_fetch_add(p, v, __ATOMIC_RELAXED, __HIP_MEMORY_SCOPE_AGENT); }
__device__ __forceinline__ unsigned xb_xcc_id() { return (unsigned)__builtin_amdgcn_s_getreg((3 << 11) | 20) & 0xFu; }
#define XB_SPIN(cond, bar) do { unsigned _sp = 0; while (cond) { __builtin_amdgcn_s_sleep(1); \
    if ((++_sp & 255u) == 0u) { if (xb_ld(&(bar)[XB_TMO])) break; if (_sp > XB_SPIN_CAP) { atomicAdd(&(bar)[XB_TMO], 1u); break; } } } } while (0)

struct XcdBarrier {
    unsigned* bar; unsigned x;
    volatile LAS unsigned* st;
};

__device__ __forceinline__ XcdBarrier xcd_barrier_post(unsigned* bar, volatile LAS unsigned* st) {
    XcdBarrier b; b.bar = bar; b.x = xb_xcc_id(); b.st = st;
    if (threadIdx.x == 0) (void)xb_add(&bar[XB_XCNT(b.x)], 1u);
    return b;
}
__device__ __forceinline__ void xcd_barrier_complete(unsigned* bar, unsigned x, unsigned& nloc, unsigned& nx) {
    const unsigned G = gridDim.x * gridDim.y * gridDim.z;
    unsigned sum, cnt, mine, sp = 0u;
    for (;;) {
        sum = 0u; cnt = 0u; mine = 0u;
#pragma unroll
        for (unsigned j = 0; j < 16; ++j) { const unsigned c = xb_ld(&bar[XB_XCNT(j)]); sum += c; cnt += (c > 0u) ? 1u : 0u; mine = (j == x) ? c : mine; }
        if (sum == G) break;
        __builtin_amdgcn_s_sleep(1);
        if ((++sp & 255u) == 0u) { if (xb_ld(&bar[XB_TMO])) break; if (sp > XB_SPIN_CAP) { atomicAdd(&bar[XB_TMO], 1u); break; } }
    }
    nloc = mine > 0u ? mine : 1u; nx = cnt > 0u ? cnt : 1u;
}

__device__ __forceinline__ void xcd_barrier(const XcdBarrier& b) {
    asm volatile("s_waitcnt vmcnt(0)" ::: "memory");
    __syncthreads();
    if (threadIdx.x == 0) {
        unsigned* bar = b.bar;
        __builtin_amdgcn_s_waitcnt(0);
        unsigned nloc = b.st[0], nx = b.st[1];
        if (nloc == 0u) { xcd_barrier_complete(bar, b.x, nloc, nx); b.st[0] = nloc; b.st[1] = nx; }
        const unsigned old = xb_add(&bar[XB_XSUB(b.x)], 1u);
        const unsigned gen = old / nloc;
        if (old + 1u == (gen + 1u) * nloc) {
            __builtin_amdgcn_fence(__ATOMIC_RELEASE, "agent");
            asm volatile("s_waitcnt vmcnt(0)" ::: "memory");
            const unsigned og = xb_add(&bar[XB_TOP], 1u);
            const unsigned tg = og / nx;
            if (og + 1u == (tg + 1u) * nx) xb_add(&bar[XB_TOPGEN], 1u);
            else XB_SPIN(xb_ld(&bar[XB_TOPGEN]) == tg, bar);
            __builtin_amdgcn_fence(__ATOMIC_ACQUIRE, "agent");
            xb_add(&bar[XB_XGEN(b.x)], 1u);
            asm volatile("s_waitcnt vmcnt(0)" ::: "memory");
        } else {
            XB_SPIN(xb_ld(&bar[XB_XGEN(b.x)]) == gen, bar);
            __builtin_amdgcn_fence(__ATOMIC_ACQUIRE, "agent");
            asm volatile("s_waitcnt vmcnt(0)" ::: "memory");
        }
    }
    __syncthreads();
}


constexpr size_t WS_BAR = 0;
#define GRID_BAR() do { XcdBarrier b_; b_.bar = (unsigned*)(kargs()->ws + WS_BAR); b_.x = xb_xcc_id(); b_.st = (volatile LAS unsigned*)(lds + LDS_MISC); xcd_barrier(b_); } while (0)

struct PrepSrc { const float* p0; const float* p1; const float* p2; const float* gain; };
template <int MODE> __device__ __forceinline__ void prep_item(const PrepSrc S, int K, int N, bf16* WT, LAS float* scr, int item, int lane) {
    const int nblk = N / 32, kb = item / nblk, nb = item % nblk, k0 = 64 * kb, n0 = 32 * nb;
    const int n = n0 + (lane & 31);
    const float* cp = nullptr; int ld = 0;
    if (MODE == 0) { cp = S.p0 + n; ld = N; }
    else if (MODE == 1) { if (n < 256) { cp = S.p0 + n; ld = 256; } else if (n < 640) { cp = S.p1 + (n - 256); ld = 384; } else if (n < 672) { const int p = n - 640; cp = S.p2 + ((p >> 1) + 16 * (p & 1)); ld = 32; } }
    else if (MODE == 2) { if (n < 1024) { cp = S.p0 + n; } else { cp = S.p1 + (n - 1024); } ld = 1024; }
    else if (MODE == 3) { const int h = n / 96, o = n % 96; int oc; if (o < 64) oc = o; else { const int p = o - 64; oc = 64 + (p >> 1) + 16 * (p & 1); } cp = S.p0 + h * 96 + oc; ld = 1536; }
    else { const int pn = n >> 8, o = n & 255; const int f = 128 * pn + (o & 127); cp = S.p0 + ((o < 128) ? f : 2816 + f); ld = 5632; }
#pragma unroll
    for (int i = 0; i < 32; ++i) { const int kk = 2 * i + (lane >> 5); float v = cp ? __builtin_nontemporal_load(cp + (size_t)(k0 + kk) * ld) : 0.f; if (MODE == 2 || MODE == 3) v *= S.gain[k0 + kk]; scr[kk * 33 + (lane & 31)] = v; }
    asm volatile("s_waitcnt lgkmcnt(0)" ::: "memory");
    const int c = lane & 7;
#pragma unroll
    for (int j = 0; j < 4; ++j) { const int nn = (lane >> 3) + 8 * j; const LAS float* s = scr + (8 * c) * 33 + nn;
        u32x4 o; o.x = pk2(s[0 * 33], s[1 * 33]); o.y = pk2(s[2 * 33], s[3 * 33]); o.z = pk2(s[4 * 33], s[5 * 33]); o.w = pk2(s[6 * 33], s[7 * 33]);
        *(u32x4*)(WT + (size_t)(n0 + nn) * K + k0 + 8 * c) = o; }
    asm volatile("s_waitcnt lgkmcnt(0)" ::: "memory");
}

__device__ __forceinline__ void ln_rows(const float* xin, const bf16* xinb, const bf16* add, const float* g, const float* b, float* xout, bf16* xb, int gw, int ngw, int lane) {
    constexpr int R = 4;
    f32x4 gv[4], bv[4];
#pragma unroll
    for (int j = 0; j < 4; ++j) { gv[j] = *((const f32x4*)g + lane + 64 * j); bv[j] = *((const f32x4*)b + lane + 64 * j); }
    for (int m0 = gw * R; m0 < M; m0 += ngw * R) {
        f32x4 v[R][4]; u32x2 av[R][4];
#pragma unroll
        for (int q = 0; q < R; ++q) { const int m = m0 + q;
            const u32x2* ar = (const u32x2*)(add + (size_t)m * D) + lane;
#pragma unroll
            for (int j = 0; j < 4; ++j) av[q][j] = __builtin_nontemporal_load(&ar[64 * j]);
            if (xin) { const f32x4* xr = (const f32x4*)(xin + (size_t)m * D) + lane;
#pragma unroll
                for (int j = 0; j < 4; ++j) v[q][j] = __builtin_nontemporal_load(&xr[64 * j]);
            } else { const u32x2* xr = (const u32x2*)(xinb + (size_t)m * D) + lane;
#pragma unroll
                for (int j = 0; j < 4; ++j) { const u32x2 x = __builtin_nontemporal_load(&xr[64 * j]); v[q][j][0] = bf_lo(x.x); v[q][j][1] = bf_hi(x.x); v[q][j][2] = bf_lo(x.y); v[q][j][3] = bf_hi(x.y); } } }
        float s[R], s2[R];
#pragma unroll
        for (int q = 0; q < R; ++q) { s[q] = 0.f; s2[q] = 0.f;
#pragma unroll
            for (int j = 0; j < 4; ++j) { const u32x2 a = av[q][j];
                v[q][j][0] = ALPHA * v[q][j][0] + bf_lo(a.x); v[q][j][1] = ALPHA * v[q][j][1] + bf_hi(a.x); v[q][j][2] = ALPHA * v[q][j][2] + bf_lo(a.y); v[q][j][3] = ALPHA * v[q][j][3] + bf_hi(a.y);
                s[q] += (v[q][j][0] + v[q][j][1]) + (v[q][j][2] + v[q][j][3]);
                s2[q] += (v[q][j][0] * v[q][j][0] + v[q][j][1] * v[q][j][1]) + (v[q][j][2] * v[q][j][2] + v[q][j][3] * v[q][j][3]); } }
#pragma unroll
        for (int o = 1; o < 64; o <<= 1) {
#pragma unroll
            for (int q = 0; q < R; ++q) { s[q] += __shfl_xor(s[q], o); s2[q] += __shfl_xor(s2[q], o); } }
#pragma unroll
        for (int q = 0; q < R; ++q) { const int m = m0 + q;
            const float mean = s[q] * (1.f / D); const float var = fmaxf(s2[q] * (1.f / D) - mean * mean, 0.f); const float rstd = 1.f / sqrtf(var + LN_EPS);
            f32x4* orow = xout ? (f32x4*)(xout + (size_t)m * D) + lane : nullptr; u32x2* brow = xb ? (u32x2*)(xb + (size_t)m * D) + lane : nullptr;
#pragma unroll
            for (int j = 0; j < 4; ++j) { const f32x4 o = (v[q][j] - mean) * rstd * gv[j] + bv[j];
                if (xout) __builtin_nontemporal_store(o, &orow[64 * j]);
                if (xb) { u32x2 w; w.x = pk2(o[0], o[1]); w.y = pk2(o[2], o[3]); brow[64 * j] = w; } } }
    }
}

__device__ __forceinline__ int crow(int r, int hi) { return (r & 3) + 8 * (r >> 2) + 4 * hi; }
__device__ __forceinline__ unsigned cvtpk(float lo, float hi) { typedef float f2 __attribute__((ext_vector_type(2))); typedef __bf16 b2 __attribute__((ext_vector_type(2))); f2 v = {lo, hi}; b2 b = __builtin_convertvector(v, b2); return __builtin_bit_cast(unsigned, b); }
typedef short s16x4 __attribute__((ext_vector_type(4)));
__device__ __forceinline__ float xhalf(float v) { const unsigned u = __float_as_uint(v); auto rr = __builtin_amdgcn_permlane32_swap(u, u, false, false); return __uint_as_float((threadIdx.x & 32) ? rr[0] : rr[1]); }
__device__ __forceinline__ s16x4 vtr(const LAS unsigned char* p) { return __builtin_bit_cast(s16x4, __builtin_amdgcn_ds_read_tr16_b64_v4i16((LAS v4i16_t*)p)); }

template <bool NT> __device__ __forceinline__ void store_o_rows(LAS unsigned char* stg, const f32x16 (&o)[2], float inv, bf16* Ohead, int tok0, int tokstep, int lane) {
    const int r32 = lane & 31, hi = lane >> 5;
#pragma unroll
    for (int db = 0; db < 2; ++db)
#pragma unroll
        for (int g = 0; g < 4; ++g) { u32x2 wv; wv.x = cvtpk(o[db][4 * g] * inv, o[db][4 * g + 1] * inv); wv.y = cvtpk(o[db][4 * g + 2] * inv, o[db][4 * g + 3] * inv);
            *(LAS u32x2*)(stg + r32 * 144 + (32 * db + 8 * g + 4 * hi) * 2) = wv; }
    asm volatile("s_waitcnt lgkmcnt(0)" ::: "memory");
#pragma unroll
    for (int i = 0; i < 4; ++i) { const int row = (lane >> 3) + 8 * i, ch = lane & 7; const u32x4 v = *(const LAS u32x4*)(stg + row * 144 + ch * 16);
        if (NT) __builtin_nontemporal_store(v, (u32x4*)(Ohead + (size_t)(tok0 + row * tokstep) * 1024 + ch * 8)); else *(u32x4*)(Ohead + (size_t)(tok0 + row * tokstep) * 1024 + ch * 8) = v; }
    asm volatile("s_waitcnt lgkmcnt(0)" ::: "memory");
}

template <int DQK> __device__ __forceinline__ void attn_unit(LAS unsigned char* lds, int mode, int b, int h, int blk, const bf16* Qp, int ldq, int qcol,
                                                            const bf16* Kp, const bf16* KRp, const bf16* Vp, bf16* Op, float* lsep) {
    constexpr int KSTR = DQK * 2 + 16, KBUF = 64 * KSTR, VBUF = 64 * 128, NKS = DQK / 16;
    const int tid = pg8::pg8_ltid(), lane = tid & 63, r32 = lane & 31, hi = lane >> 5; const int w = __builtin_amdgcn_readfirstlane(tid >> 6);
    LAS unsigned char* Kl = lds; LAS unsigned char* Vl = lds + 2 * KBUF;
    int d = 1, res = 0, qs0 = 0, ks0 = 0, nt = 4, qs_w, res_w, maxback = 128; float slope2 = 0.f;
    if (mode == 0) { qs0 = 256 * blk; nt = 4 * (blk + 1); maxback = 1 << 30; }
    else { const float sl = exp2f(-0.5f * (float)(h + 1)) * LOG2E;
        if (mode == 1) { qs0 = 256 * blk; ks0 = qs0 >= 128 ? qs0 - 128 : 0; nt = (qs0 + 256 - ks0) >> 6; slope2 = sl; }
        else if (mode == 2) { d = 4; res = blk >> 1; qs0 = 256 * (blk & 1); ks0 = qs0 >= 128 ? qs0 - 128 : 0; nt = (qs0 + 256 - ks0) >> 6; slope2 = sl * 4.f; }
        else { d = 16; nt = 4; slope2 = sl * 16.f; } }
    if (mode == 3) { qs_w = 32 * (w & 3); res_w = 2 * blk + (w >> 2); } else { qs_w = qs0 + 32 * w; res_w = res; }
    const int tokbase = b * SEQ;
    const int tq = tokbase + (qs_w + r32) * d + res_w;
    const int srow = tid >> 3, sch = tid & 7, rrow = (tid >> 2) & 63, rch = tid & 3;
    u32x4 kreg0, vreg0, rreg0, kreg1, vreg1, rreg1;
#define ATT_TOK(t, j) (mode == 3 ? tokbase + (32 * (t) + ((j) & 31)) * 16 + 2 * blk + ((j) >> 5) : tokbase + (ks0 + 64 * (t) + (j)) * d + res)
#define ATT_LOAD(S, t) do { const size_t tk = (size_t)ATT_TOK(t, srow); const size_t hk_ = ((size_t)(b * 16 + h) * 2048 + (tk - tokbase)) * 64 + sch * 8; kreg##S = *(const u32x4*)(Kp + hk_); vreg##S = *(const u32x4*)(Vp + hk_); \
        if (DQK == 96 && tid < 256) { const size_t tr = (size_t)ATT_TOK(t, rrow); rreg##S = *(const u32x4*)(KRp + tr * 32 + rch * 8); } } while (0)
#define ATT_STORE(S, buf) do { *(LAS u32x4*)(Kl + (buf) * KBUF + srow * KSTR + sch * 16) = kreg##S; \
        *(LAS u32x4*)(Vl + (buf) * VBUF + srow * 128 + (((sch >> 2) ^ ((srow >> 1) & 1)) * 64) + (sch & 3) * 16) = vreg##S; \
        if (DQK == 96 && tid < 256) *(LAS u32x4*)(Kl + (buf) * KBUF + rrow * KSTR + 128 + rch * 16) = rreg##S; } while (0)
    bf16x8 qf[NKS];
#pragma unroll
    for (int d0 = 0; d0 < NKS; ++d0) qf[d0] = *(const bf16x8*)(Qp + ((size_t)(b * 16 + h) * 2048 + (tq - tokbase)) * DQK + d0 * 16 + hi * 8);
    const bool rev = (mode != 0);
#define ATT_SEQ(i) (rev ? nt - 1 - (i) : (i))
    ATT_LOAD(0, ATT_SEQ(0));
    ATT_LOAD(1, ATT_SEQ(1));
    ATT_STORE(0, 0);
    __syncthreads();
    const float NEG = -1e30f, THR = 8.0f;
    float mrun = 0.f, lrun = 0.f; f32x16 o[2]; o[0] = (f32x16){}; o[1] = (f32x16){};
    bool first = true;
    const int q4 = (lane & 15) >> 2, p4 = lane & 3, g1 = (lane >> 4) & 1;
    const int voff = q4 * 128 + g1 * 32 + p4 * 8 + hi * 4 * 128;
    const int vsw = (q4 >> 1) & 1;
    auto tile_compute = [&](const int t, const int buf) __attribute__((always_inline)) {
        const int bA = rev ? 1 : 0, bB = 1 - bA;
        bool actA, actB, intA, intB; int kbA, kbB;
#define ATT_CLASS(b2, act_, int_, kb_) do { \
            if (mode == 0) { kb_ = 64 * t + 32 * (b2); act_ = kb_ <= qs_w + 31; int_ = kb_ + 31 <= qs_w; } \
            else if (mode == 3) { kb_ = 32 * t; act_ = ((b2) == (w >> 2)) && (32 * t <= qs_w + 31); int_ = kb_ + 31 <= qs_w; } \
            else { kb_ = ks0 + 64 * t + 32 * (b2); act_ = (kb_ <= qs_w + 31) && (kb_ + 31 >= qs_w - 128); int_ = (kb_ + 31 <= qs_w) && (qs_w + 31 - kb_ <= 128); } } while (0)
        ATT_CLASS(bA, actA, intA, kbA); ATT_CLASS(bB, actB, intB, kbB);
#define ATT_INIT(a, kb_, int_) do { const int base_ = (qs_w + r32) - (kb_) - 4 * hi; const float t0_ = -(slope2 * (float)base_ + mrun); \
            if (int_) { _Pragma("unroll") for (int r = 0; r < 16; ++r) a[r] = fmaf(slope2, (float)((r & 3) + 8 * (r >> 2)), t0_); } \
            else { _Pragma("unroll") for (int r = 0; r < 16; ++r) { const int delta_ = base_ - ((r & 3) + 8 * (r >> 2)); a[r] = ((unsigned)delta_ <= (unsigned)maxback) ? fmaf(slope2, (float)((r & 3) + 8 * (r >> 2)), t0_) : NEG; } } } while (0)
#define ATT_KREAD(kf, b2) do { const LAS unsigned char* kp_ = Kl + buf * KBUF + (32 * (b2) + r32) * KSTR + hi * 16; _Pragma("unroll") for (int d0 = 0; d0 < NKS; ++d0) kf[d0] = *(const LAS bf16x8*)(kp_ + d0 * 32); } while (0)
#define ATT_VREAD(vl, vh, b2) do { _Pragma("unroll") for (int s = 0; s < 2; ++s) { const LAS unsigned char* vp_ = Vl + buf * VBUF + voff + (32 * (b2) + 16 * s) * 128; \
            _Pragma("unroll") for (int db = 0; db < 2; ++db) { vl[s][db] = vtr(vp_ + ((db ^ vsw) * 64)); vh[s][db] = vtr(vp_ + 8 * 128 + ((db ^ vsw) * 64)); } } } while (0)
#define ATT_PACK(pf, e) do { _Pragma("unroll") for (int s = 0; s < 2; ++s) { u32x4 pw_; pw_.x = cvtpk(e[8 * s + 0], e[8 * s + 1]); pw_.y = cvtpk(e[8 * s + 2], e[8 * s + 3]); pw_.z = cvtpk(e[8 * s + 4], e[8 * s + 5]); pw_.w = cvtpk(e[8 * s + 6], e[8 * s + 7]); pf[s] = __builtin_bit_cast(bf16x8, pw_); } } while (0)
#define ATT_VF(vl, vh, s, db) (bf16x8){vl[s][db][0], vl[s][db][1], vl[s][db][2], vl[s][db][3], vh[s][db][0], vh[s][db][1], vh[s][db][2], vh[s][db][3]}
#define ATT_SB() __builtin_amdgcn_sched_barrier(0)
#define ATT_EXPS(X, lo, hi_, ls_) do { _Pragma("unroll") for (int r = (lo); r < (hi_); ++r) { const float ev_ = __builtin_amdgcn_exp2f(X[r]); X[r] = ev_; ls_ += ev_; } } while (0)
#define ATT_MAX16(X, m_) do { m_ = NEG; _Pragma("unroll") for (int r = 0; r < 16; ++r) m_ = fmaxf(m_, X[r]); m_ = fmaxf(m_, xhalf(m_)); } while (0)
        if (actA && actB && !first) {
            f32x16 pA, pB; float lsA = 0.f, lsB = 0.f, dlA = 0.f, dlB = 0.f; bool needA = false, needB = false; bf16x8 kfa[NKS], kfb[NKS];
            ATT_KREAD(kfa, bA); ATT_INIT(pA, kbA, intA); ATT_INIT(pB, kbB, intB);
            ATT_SB();
#pragma unroll
            for (int d0 = 0; d0 < NKS; ++d0) pA = __builtin_amdgcn_mfma_f32_32x32x16_bf16(kfa[d0], qf[d0], pA, 0, 0, 0);
            ATT_KREAD(kfb, bB);
            ATT_SB();
            s16x4 vla[2][2], vha[2][2], vlb[2][2], vhb[2][2];
#pragma unroll
            for (int d0 = 0; d0 < NKS; ++d0) {
                pB = __builtin_amdgcn_mfma_f32_32x32x16_bf16(kfb[d0], qf[d0], pB, 0, 0, 0);
                if (d0 == 0) { float mtA; ATT_MAX16(pA, mtA); needA = __any(mtA > THR);
                    if (needA) { dlA = fmaxf(mtA, 0.f); const float alpha = __builtin_amdgcn_exp2f(-dlA); mrun += dlA; lrun *= alpha;
#pragma unroll
                        for (int r = 0; r < 16; ++r) { o[0][r] *= alpha; o[1][r] *= alpha; pA[r] -= dlA; } } }
                else if (NKS == 6) { if (d0 <= 4) ATT_EXPS(pA, 4 * (d0 - 1), 4 * d0, lsA); }
                else { if (d0 == 1) ATT_EXPS(pA, 0, 6, lsA); else if (d0 == 2) ATT_EXPS(pA, 6, 11, lsA); else ATT_EXPS(pA, 11, 16, lsA); }
                if (d0 == NKS - 1) ATT_VREAD(vla, vha, bA);
                ATT_SB();
            }
            bf16x8 pfA[2], pfB[2];
            ATT_PACK(pfA, pA);
            ATT_SB();
#pragma unroll
            for (int s = 0; s < 2; ++s)
#pragma unroll
                for (int db = 0; db < 2; ++db) {
                    o[db] = __builtin_amdgcn_mfma_f32_32x32x16_bf16(ATT_VF(vla, vha, s, db), pfA[s], o[db], 0, 0, 0);
                    const int g = 2 * s + db;
                    if (g == 0) { if (needA) {
#pragma unroll
                            for (int r = 0; r < 16; ++r) pB[r] -= dlA; }
                        float mtB; ATT_MAX16(pB, mtB); needB = __any(mtB > THR);
                        if (needB) { dlB = fmaxf(mtB, 0.f);
#pragma unroll
                            for (int r = 0; r < 16; ++r) pB[r] -= dlB; } }
                    else if (g == 1) ATT_EXPS(pB, 0, 6, lsB); else if (g == 2) ATT_EXPS(pB, 6, 11, lsB); else ATT_EXPS(pB, 11, 16, lsB);
                    if (g == 3) ATT_VREAD(vlb, vhb, bB);
                    ATT_SB();
                }
            ATT_PACK(pfB, pB);
            if (needB) { const float alpha = __builtin_amdgcn_exp2f(-dlB); mrun += dlB; lrun = (lrun + lsA) * alpha;
#pragma unroll
                for (int r = 0; r < 16; ++r) { o[0][r] *= alpha; o[1][r] *= alpha; } }
            else lrun += lsA;
#pragma unroll
            for (int s = 0; s < 2; ++s)
#pragma unroll
                for (int db = 0; db < 2; ++db) o[db] = __builtin_amdgcn_mfma_f32_32x32x16_bf16(ATT_VF(vlb, vhb, s, db), pfB[s], o[db], 0, 0, 0);
            lrun += lsB;
        } else if (actA || actB) {
#pragma unroll
            for (int k2 = 0; k2 < 2; ++k2) if (k2 == 0 ? actA : actB) {
                const int b2 = k2 == 0 ? bA : bB; const int kbx = k2 == 0 ? kbA : kbB; const bool intx = k2 == 0 ? intA : intB;
                f32x16 a; bf16x8 kf[NKS]; s16x4 vl[2][2], vh[2][2];
                ATT_KREAD(kf, b2); ATT_INIT(a, kbx, intx);
#pragma unroll
                for (int d0 = 0; d0 < NKS; ++d0) a = __builtin_amdgcn_mfma_f32_32x32x16_bf16(kf[d0], qf[d0], a, 0, 0, 0);
                ATT_VREAD(vl, vh, b2);
                float mt; ATT_MAX16(a, mt);
                if (first || __any(mt > 0.f)) {
                    const float dl = first ? mt : fmaxf(mt, 0.f);
                    const float alpha = first ? 1.0f : __builtin_amdgcn_exp2f(-dl); mrun += dl; lrun *= alpha;
#pragma unroll
                    for (int r = 0; r < 16; ++r) { o[0][r] *= alpha; o[1][r] *= alpha; a[r] -= dl; }
                    first = false;
                }
                float ls = 0.f;
                ATT_EXPS(a, 0, 16, ls);
                lrun += ls;
                bf16x8 pf[2]; ATT_PACK(pf, a);
#pragma unroll
                for (int s = 0; s < 2; ++s)
#pragma unroll
                    for (int db = 0; db < 2; ++db) o[db] = __builtin_amdgcn_mfma_f32_32x32x16_bf16(ATT_VF(vl, vh, s, db), pf[s], o[db], 0, 0, 0);
            }
        }
    };
    for (int it = 0; it < nt; it += 2) {
        if (it + 2 < nt) ATT_LOAD(0, ATT_SEQ(it + 2));
        tile_compute(ATT_SEQ(it), 0);
        ATT_STORE(1, 1);
        __syncthreads();
        if (it + 3 < nt) ATT_LOAD(1, ATT_SEQ(it + 3));
        tile_compute(ATT_SEQ(it + 1), 1);
        if (it + 2 < nt) ATT_STORE(0, 0);
        __syncthreads();
    }
    const float ltot = lrun + xhalf(lrun); const float inv = 1.0f / ltot;
    store_o_rows<false>(lds + LDS_OST + w * OST_WAVE, o, inv, Op + h * 64, tokbase + qs_w * d + res_w, d, lane);
    if (lsep && hi == 0) lsep[(size_t)tq * 16 + h] = mrun + log2f(ltot);
#undef ATT_TOK
#undef ATT_SEQ
#undef ATT_CLASS
#undef ATT_EXPS
#undef ATT_MAX16
#undef ATT_INIT
#undef ATT_KREAD
#undef ATT_VREAD
#undef ATT_PACK
#undef ATT_VF
#undef ATT_SB
#undef ATT_LOAD
#undef ATT_STORE
}

__device__ __forceinline__ void dil_phase(LAS unsigned char* lds, int bhbase, int member, const bf16* Qp, const bf16* Kp, const bf16* Vp, bf16* Opart, size_t ostride, float* lse) {
    constexpr int KSTR = 144, KBYTES = 384 * KSTR, NKS = 4;
    const int tid = pg8::pg8_ltid(), lane = tid & 63, r32 = lane & 31, hi = lane >> 5; const int w = __builtin_amdgcn_readfirstlane(tid >> 6);
    LAS unsigned char* Kl = lds; LAS unsigned char* Vl = lds + KBYTES;
    const int srow = tid >> 3, sch = tid & 7;
    const int q4 = (lane & 15) >> 2, p4 = lane & 3, g1 = (lane >> 4) & 1;
    const int voff = q4 * 128 + g1 * 32 + p4 * 8 + hi * 4 * 128, vsw = (q4 >> 1) & 1;
    const float NEG = -1e30f;
    u32x4 kr[6], vr[6]; bf16x8 qn[NKS];
#define DIL_GEOM(k) const int st_ = (k) / 3, mode = 1 + (k) % 3, blk = (member + st_) & 7, bh = bhbase + st_; const int b = bh >> 4, h = bh & 15, tokbase = b * SEQ; int d, res, qs0, ks0, nrows; \
        if (mode == 1) { d = 1; res = 0; qs0 = 256 * blk; ks0 = qs0 >= 128 ? qs0 - 128 : 0; nrows = qs0 + 256 - ks0; } \
        else if (mode == 2) { d = 4; res = blk >> 1; qs0 = 256 * (blk & 1); ks0 = qs0 >= 128 ? qs0 - 128 : 0; nrows = qs0 + 256 - ks0; } \
        else { d = 16; res = 0; qs0 = 0; ks0 = 0; nrows = 256; } \
        const int qs_w = mode == 3 ? 32 * (w & 3) : qs0 + 32 * w, res_w = mode == 3 ? 2 * blk + (w >> 2) : res; \
        const int tq = tokbase + (qs_w + r32) * d + res_w;
#define DIL_FETCH(k) do { DIL_GEOM(k) (void)qs_w; \
        _Pragma("unroll") for (int jj = 0; jj < 6; ++jj) if (64 * jj < nrows) { const int row = srow + 64 * jj; \
            const size_t tk = (size_t)(mode == 3 ? tokbase + (row & 127) * 16 + 2 * blk + (row >> 7) : tokbase + (ks0 + row) * d + res); \
            const size_t hk_ = ((size_t)bh * 2048 + (tk - tokbase)) * 64 + sch * 8; kr[jj] = *(const u32x4*)(Kp + hk_); vr[jj] = *(const u32x4*)(Vp + hk_); } \
        _Pragma("unroll") for (int d0 = 0; d0 < NKS; ++d0) qn[d0] = *(const bf16x8*)(Qp + ((size_t)bh * 2048 + (tq - tokbase)) * 64 + d0 * 16 + hi * 8); } while (0)
    DIL_FETCH(0);
    for (int u = 0; u < 24; ++u) {
        DIL_GEOM(u)
#pragma unroll
        for (int jj = 0; jj < 6; ++jj) if (64 * jj < nrows) { const int row = srow + 64 * jj;
            *(LAS u32x4*)(Kl + row * KSTR + sch * 16) = kr[jj];
            *(LAS u32x4*)(Vl + row * 128 + (((sch >> 2) ^ ((row >> 1) & 1)) * 64) + (sch & 3) * 16) = vr[jj]; }
        bf16x8 qf[NKS];
#pragma unroll
        for (int d0 = 0; d0 < NKS; ++d0) qf[d0] = qn[d0];
        __syncthreads();
        if (u + 1 < 24) DIL_FETCH(u + 1);
        const float slope2 = exp2f(-0.5f * (float)(h + 1)) * LOG2E * (float)d;
        const int kbi0 = mode == 3 ? (w & 3) : (qs_w - ks0) >> 5;
        const int nblk = kbi0 + 1 < 5 ? kbi0 + 1 : 5;
        const int rowoff = mode == 3 ? 128 * (w >> 2) : 0;
        float mrun = 0.f, lrun = 0.f; f32x16 o[2]; o[0] = (f32x16){}; o[1] = (f32x16){};
        for (int i = 0; i < nblk; i += 2) {
            const bool hasB = i + 1 < nblk;
            const int kbiA = kbi0 - i, kbiB = hasB ? kbiA - 1 : kbiA;
            const int rbA = rowoff + 32 * kbiA, kbA = ks0 + 32 * kbiA, rbB = rowoff + 32 * kbiB, kbB = ks0 + 32 * kbiB;
            bf16x8 kfA[NKS], kfB[NKS];
            { const LAS unsigned char* kp = Kl + (rbA + r32) * KSTR + hi * 16;
#pragma unroll
              for (int d0 = 0; d0 < NKS; ++d0) kfA[d0] = *(const LAS bf16x8*)(kp + d0 * 32); }
            { const LAS unsigned char* kp = Kl + (rbB + r32) * KSTR + hi * 16;
#pragma unroll
              for (int d0 = 0; d0 < NKS; ++d0) kfB[d0] = *(const LAS bf16x8*)(kp + d0 * 32); }
            f32x16 aA, aB;
#define DIL_INIT(a, kb_) do { const bool inter_ = ((kb_) + 31 <= qs_w) && (qs_w + 31 - (kb_) <= 128); const int base_ = (qs_w + r32) - (kb_) - 4 * hi; const float t0_ = -(slope2 * (float)base_ + mrun); \
              if (inter_) { _Pragma("unroll") for (int r = 0; r < 16; ++r) a[r] = fmaf(slope2, (float)((r & 3) + 8 * (r >> 2)), t0_); } \
              else { _Pragma("unroll") for (int r = 0; r < 16; ++r) { const int delta_ = base_ - ((r & 3) + 8 * (r >> 2)); a[r] = ((unsigned)delta_ <= 128u) ? fmaf(slope2, (float)((r & 3) + 8 * (r >> 2)), t0_) : NEG; } } } while (0)
            DIL_INIT(aA, kbA);
            if (hasB) DIL_INIT(aB, kbB); else {
#pragma unroll
                for (int r = 0; r < 16; ++r) aB[r] = NEG; }
#pragma unroll
            for (int d0 = 0; d0 < NKS; ++d0) {
                aA = __builtin_amdgcn_mfma_f32_32x32x16_bf16(kfA[d0], qf[d0], aA, 0, 0, 0);
                if (hasB) aB = __builtin_amdgcn_mfma_f32_32x32x16_bf16(kfB[d0], qf[d0], aB, 0, 0, 0); }
            s16x4 vlA[2][2], vhA[2][2], vlB[2][2], vhB[2][2];
#pragma unroll
            for (int s = 0; s < 2; ++s) { const LAS unsigned char* vpA = Vl + voff + (rbA + 16 * s) * 128; const LAS unsigned char* vpB = Vl + voff + (rbB + 16 * s) * 128;
#pragma unroll
                for (int db = 0; db < 2; ++db) { vlA[s][db] = vtr(vpA + ((db ^ vsw) * 64)); vhA[s][db] = vtr(vpA + 8 * 128 + ((db ^ vsw) * 64));
                                                 vlB[s][db] = vtr(vpB + ((db ^ vsw) * 64)); vhB[s][db] = vtr(vpB + 8 * 128 + ((db ^ vsw) * 64)); } }
            float mt = NEG;
#pragma unroll
            for (int r = 0; r < 16; ++r) mt = fmaxf(mt, fmaxf(aA[r], aB[r]));
            mt = fmaxf(mt, xhalf(mt));
            if (i == 0 || __any(mt > 0.f)) {
                const float dl = i == 0 ? mt : fmaxf(mt, 0.f);
                const float alpha = i == 0 ? 1.0f : __builtin_amdgcn_exp2f(-dl); mrun += dl; lrun *= alpha;
#pragma unroll
                for (int r = 0; r < 16; ++r) { o[0][r] *= alpha; o[1][r] *= alpha; aA[r] -= dl; aB[r] -= dl; }
            }
            float ls = 0.f;
#pragma unroll
            for (int r = 0; r < 16; ++r) { aA[r] = __builtin_amdgcn_exp2f(aA[r]); ls += aA[r]; }
            if (hasB) {
#pragma unroll
                for (int r = 0; r < 16; ++r) { aB[r] = __builtin_amdgcn_exp2f(aB[r]); ls += aB[r]; } }
            lrun += ls;
#pragma unroll
            for (int s = 0; s < 2; ++s) {
                u32x4 pw; pw.x = cvtpk(aA[8 * s + 0], aA[8 * s + 1]); pw.y = cvtpk(aA[8 * s + 2], aA[8 * s + 3]); pw.z = cvtpk(aA[8 * s + 4], aA[8 * s + 5]); pw.w = cvtpk(aA[8 * s + 6], aA[8 * s + 7]);
                const bf16x8 pf = __builtin_bit_cast(bf16x8, pw);
#pragma unroll
                for (int db = 0; db < 2; ++db) {
                    const bf16x8 vf = (bf16x8){vlA[s][db][0], vlA[s][db][1], vlA[s][db][2], vlA[s][db][3], vhA[s][db][0], vhA[s][db][1], vhA[s][db][2], vhA[s][db][3]};
                    o[db] = __builtin_amdgcn_mfma_f32_32x32x16_bf16(vf, pf, o[db], 0, 0, 0); }
            }
            if (hasB) {
#pragma unroll
                for (int s = 0; s < 2; ++s) {
                    u32x4 pw; pw.x = cvtpk(aB[8 * s + 0], aB[8 * s + 1]); pw.y = cvtpk(aB[8 * s + 2], aB[8 * s + 3]); pw.z = cvtpk(aB[8 * s + 4], aB[8 * s + 5]); pw.w = cvtpk(aB[8 * s + 6], aB[8 * s + 7]);
                    const bf16x8 pf = __builtin_bit_cast(bf16x8, pw);
#pragma unroll
                    for (int db = 0; db < 2; ++db) {
                        const bf16x8 vf = (bf16x8){vlB[s][db][0], vlB[s][db][1], vlB[s][db][2], vlB[s][db][3], vhB[s][db][0], vhB[s][db][1], vhB[s][db][2], vhB[s][db][3]};
                        o[db] = __builtin_amdgcn_mfma_f32_32x32x16_bf16(vf, pf, o[db], 0, 0, 0); }
                } }
        }
#undef DIL_INIT
        const float ltot = lrun + xhalf(lrun); const float inv = 1.0f / ltot;
        store_o_rows<true>(lds + LDS_OST + w * OST_WAVE, o, inv, Opart + (size_t)(mode - 1) * ostride + h * 64, tokbase + qs_w * d + res_w, d, lane);
        if (hi == 0) lse[(size_t)(mode - 1) * M * 16 + (size_t)tq * 16 + h] = mrun + log2f(ltot);
        __syncthreads();
    }
#undef DIL_GEOM
#undef DIL_FETCH
}

struct Args { const float* in[20]; float* out; unsigned char* ws; };

typedef const __attribute__((address_space(4))) Args* KArgsP;
__device__ __forceinline__ KArgsP kargs() { KArgsP p = (KArgsP)__builtin_amdgcn_kernarg_segment_ptr(); asm volatile("" : "+s"(p)); return p; }
#define WSP(T, off) ((T*)(pa->ws + (off)))

__global__ void __launch_bounds__(NTHREADS, 2) yoco_fwd(Args args_unused) {
    extern __shared__ __attribute__((aligned(16))) unsigned char lds_raw[];
    LAS unsigned char* lds = (LAS unsigned char*)lds_raw;
    cg::grid_group grid = cg::this_grid();
#define PHASE_IDS const int tid = pg8::pg8_ltid(), lane = tid & 63; const int wave = __builtin_amdgcn_readfirstlane(tid >> 6); int bid = blockIdx.x; asm volatile("" : "+s"(bid)); \
    const int G = gridDim.x; const int gw = bid * NWAVES + wave, ngw = G * NWAVES; const int gtid = bid * NTHREADS + tid, gthreads = G * NTHREADS; (void)lane; (void)gw; (void)ngw; (void)gtid; (void)gthreads;

    if (threadIdx.x < 2) ((LAS unsigned*)(lds + LDS_MISC))[threadIdx.x] = 0u;
    __syncthreads();
    {
        KArgsP pa = kargs(); PHASE_IDS
        LAS float* scr = (LAS float*)(lds + wave * 16384);
        constexpr int I0 = 16 * 96, I1 = 16 * 32, I2 = 16 * 24, I3 = 4 * 64, I4 = 6 * 48, I5 = 16 * 32, I6 = 16 * 176, I7 = 44 * 32;
        constexpr int NIT = I0 + I1 + I2 + I3 + I4 + I5 + 2 * I6 + 2 * I7;
        for (int it = gw; it < NIT; it += ngw) {
            int r = it;
            if (r < I0) { prep_item<0>(PrepSrc{pa->in[1], nullptr, nullptr, nullptr}, 1024, 3072, WSP(bf16, WS_WQKV), scr, r, lane); continue; } r -= I0;
            if (r < I1) { prep_item<0>(PrepSrc{pa->in[2], nullptr, nullptr, nullptr}, 1024, 1024, WSP(bf16, WS_WOA), scr, r, lane); continue; } r -= I1;
            if (r < I2) { prep_item<1>(PrepSrc{pa->in[3], pa->in[8], pa->in[5], nullptr}, 1024, 768, WSP(bf16, WS_WLAT), scr, r, lane); continue; } r -= I2;
            if (r < I3) { prep_item<2>(PrepSrc{pa->in[6], pa->in[7], nullptr, pa->in[4]}, 256, 2048, WSP(bf16, WS_WUKV), scr, r, lane); continue; } r -= I3;
            if (r < I4) { prep_item<3>(PrepSrc{pa->in[10], nullptr, nullptr, pa->in[9]}, 384, 1536, WSP(bf16, WS_WUQ), scr, r, lane); continue; } r -= I4;
            if (r < I5) { prep_item<0>(PrepSrc{pa->in[11], nullptr, nullptr, nullptr}, 1024, 1024, WSP(bf16, WS_WOB), scr, r, lane); continue; } r -= I5;
            if (r < I6) { prep_item<4>(PrepSrc{pa->in[12], nullptr, nullptr, nullptr}, 1024, 5632, WSP(bf16, WS_WIN0), scr, r, lane); continue; } r -= I6;
            if (r < I6) { prep_item<4>(PrepSrc{pa->in[12] + (size_t)1024 * 5632, nullptr, nullptr, nullptr}, 1024, 5632, WSP(bf16, WS_WIN1), scr, r, lane); continue; } r -= I6;
            if (r < I7) { prep_item<0>(PrepSrc{pa->in[15], nullptr, nullptr, nullptr}, 2816, 1024, WSP(bf16, WS_WOUT0), scr, r, lane); continue; } r -= I7;
            prep_item<0>(PrepSrc{pa->in[15] + (size_t)2816 * 1024, nullptr, nullptr, nullptr}, 2816, 1024, WSP(bf16, WS_WOUT1), scr, r, lane);
        }
        float* rope = WSP(float, WS_ROPE);
        for (int i = gtid; i < SEQ * 16; i += gthreads) {
            const int t = i >> 4, k = i & 15; double f = 1.0; for (int j = 0; j < k; ++j) f *= 0.5623413251903491;
            const float inv_freq = (float)f; const float ang = (float)t * inv_freq;
            const double rev = (double)ang * 0.15915494309189535; const double fr = rev - __builtin_rint(rev);
            rope[2 * i] = __builtin_amdgcn_cosf((float)fr); rope[2 * i + 1] = __builtin_amdgcn_sinf((float)fr);
        }
        if (bid == 0) { unsigned* bw = WSP(unsigned, WS_BAR); for (int i = tid; i < XCD_BAR_WORDS; i += NTHREADS) bw[i] = 0u; }
        { float* rs0 = WSP(float, WS_RS); for (int i = gtid; i < M * 2; i += gthreads) rs0[i] = 0.f; }
        const float* x_in = pa->in[0]; bf16* XB = WSP(bf16, WS_XB);
        for (size_t i = gtid; i < (size_t)M * D / 8; i += gthreads) {
            const f32x4 a = __builtin_nontemporal_load((const f32x4*)x_in + 2 * i), c = __builtin_nontemporal_load((const f32x4*)x_in + 2 * i + 1);
            u32x4 o; o.x = pk2(a[0], a[1]); o.y = pk2(a[2], a[3]); o.z = pk2(c[0], c[1]); o.w = pk2(c[2], c[3]); ((u32x4*)XB)[i] = o; }
    }
    grid.sync();
    (void)xcd_barrier_post((unsigned*)(kargs()->ws + WS_BAR), (volatile LAS unsigned*)(lds + LDS_MISC));

    for (int layer = 0; layer < 2; ++layer) {
        if (layer == 0) {
            { KArgsP pa = kargs(); PHASE_IDS
              pg8::Gemm g{WSP(bf16, WS_XB), WSP(bf16, WS_WQKV), M, 3072, 1024, 1024, 1024}; pg8::StaticOrder S; S.init(M, 3072, G, bid);
              pg8::EpiQKV E{WSP(bf16, WS_R1), (size_t)(WS_R2 - WS_R1) / 2, 0.125f * LOG2E};
              pg8::gemm_phase<pg8::EpiQKV, pg8::StaticOrder, true, true>(lds, g, S, E); }
            GRID_BAR();
            { KArgsP pa = kargs(); PHASE_IDS
              for (int grp = bid; grp < BATCH * NH; grp += G) { const int x = grp & 7, i = grp >> 3;
                  dil_phase(lds, x * 32 + (i >> 3) * 8, i & 7, WSP(bf16, WS_R1), WSP(bf16, WS_R2), WSP(bf16, WS_R3), WSP(bf16, WS_R4), (size_t)(WS_R5 - WS_R4) / 2, WSP(float, WS_LSE)); } }
            GRID_BAR();
            { KArgsP pa = kargs(); PHASE_IDS
              const float* LSE = WSP(float, WS_LSE); const bf16 *R4 = WSP(bf16, WS_R4), *R5 = WSP(bf16, WS_R5), *R6 = WSP(bf16, WS_R6); bf16* R1 = WSP(bf16, WS_R1);
              for (size_t it = gtid; it < (size_t)M * 128; it += gthreads) {
                const size_t tok = it >> 7; const int c8 = (int)(it & 127), hh = c8 >> 3;
                const float l0 = LSE[tok * 16 + hh], l1 = LSE[(size_t)M * 16 + tok * 16 + hh], l2 = LSE[(size_t)2 * M * 16 + tok * 16 + hh];
                const float mx = fmaxf(l0, fmaxf(l1, l2)); float w0 = exp2f(l0 - mx), w1 = exp2f(l1 - mx), w2 = exp2f(l2 - mx); const float inv = 1.0f / (w0 + w1 + w2); w0 *= inv; w1 *= inv; w2 *= inv;
                const u32x4 a = __builtin_nontemporal_load((const u32x4*)(R4 + tok * 1024 + c8 * 8)), bq = __builtin_nontemporal_load((const u32x4*)(R5 + tok * 1024 + c8 * 8)), c = __builtin_nontemporal_load((const u32x4*)(R6 + tok * 1024 + c8 * 8));
                u32x4 o;
                o.x = pk2(w0 * bf_lo(a.x) + w1 * bf_lo(bq.x) + w2 * bf_lo(c.x), w0 * bf_hi(a.x) + w1 * bf_hi(bq.x) + w2 * bf_hi(c.x));
                o.y = pk2(w0 * bf_lo(a.y) + w1 * bf_lo(bq.y) + w2 * bf_lo(c.y), w0 * bf_hi(a.y) + w1 * bf_hi(bq.y) + w2 * bf_hi(c.y));
                o.z = pk2(w0 * bf_lo(a.z) + w1 * bf_lo(bq.z) + w2 * bf_lo(c.z), w0 * bf_hi(a.z) + w1 * bf_hi(bq.z) + w2 * bf_hi(c.z));
                o.w = pk2(w0 * bf_lo(a.w) + w1 * bf_lo(bq.w) + w2 * bf_lo(c.w), w0 * bf_hi(a.w) + w1 * bf_hi(bq.w) + w2 * bf_hi(c.w));
                *(u32x4*)(R1 + tok * 1024 + c8 * 8) = o;
              } }
            GRID_BAR();
        } else {
            { KArgsP pa = kargs(); PHASE_IDS
              pg8::Gemm g{WSP(bf16, WS_XB), WSP(bf16, WS_WLAT), M, NLAT, 1024, 1024, 1024}; pg8::StaticOrder S; S.init(M, NLAT, G, bid);
              pg8::EpiLat E{WSP(bf16, WS_R1), WSP(float, WS_RS), WSP(float, WS_ROPE), WSP(bf16, WS_KR)};
              pg8::gemm_phase<pg8::EpiLat, pg8::StaticOrder, true, true>(lds, g, S, E); }
            GRID_BAR();
            { KArgsP pa = kargs(); PHASE_IDS
              pg8::Gemm g{WSP(bf16, WS_R1), WSP(bf16, WS_WUKV), M, 2048, KVR, NLAT, KVR}; pg8::StaticOrder S; S.init(M, 2048, G, bid);
              pg8::EpiMla E{WSP(bf16, WS_R2), 64, 1024, (size_t)(WS_R3 - WS_R2) / 2, WSP(float, WS_RS), 0, 1.f, WSP(float, WS_ROPE), 0, 1.f / KVR};
              pg8::gemm_phase<pg8::EpiMla, pg8::StaticOrder, true, true>(lds, g, S, E); }
            { KArgsP pa = kargs(); PHASE_IDS
              pg8::Gemm g{WSP(bf16, WS_R1) + 256, WSP(bf16, WS_WUQ), M, NQ, QR, NLAT, QR}; pg8::StaticOrder S; S.init(M, NQ, G, bid);
              pg8::EpiMla E{WSP(bf16, WS_R4), 96, 0, 0, WSP(float, WS_RS), 1, 0.10206207261596577f * LOG2E, WSP(float, WS_ROPE), 1, 1.f / QR};
              pg8::gemm_phase<pg8::EpiMla, pg8::StaticOrder, true, true>(lds, g, S, E); }
            GRID_BAR();
            { KArgsP pa = kargs(); PHASE_IDS
              for (int grp = bid; grp < BATCH * NH; grp += G) { const int x = grp & 7, i = grp >> 3, bhbase = x * 32 + (i >> 2) * 4, mem = i & 3;
                for (int st = 0; st < 4; ++st) { const int bh = bhbase + st;
                  for (int half = 0; half < 2; ++half) { const int qb = half == 0 ? 7 - mem : mem;
                    attn_unit<96>(lds, 0, bh >> 4, bh & 15, qb, WSP(bf16, WS_R4), NQ, (bh & 15) * 96, WSP(bf16, WS_R2), WSP(bf16, WS_KR), WSP(bf16, WS_R3), WSP(bf16, WS_R1), nullptr); } } } }
            GRID_BAR();
        }
        { KArgsP pa = kargs(); PHASE_IDS
          pg8::Gemm g{WSP(bf16, WS_R1), layer == 0 ? WSP(bf16, WS_WOA) : WSP(bf16, WS_WOB), M, 1024, 1024, 1024, 1024}; pg8::StaticOrder S; S.init(M, 1024, G, bid);
          pg8::EpiBf16<0> E{WSP(bf16, WS_R2), 1024, nullptr, 0, 0, 1.f};
          pg8::gemm_phase<pg8::EpiBf16<0>, pg8::StaticOrder, true, true>(lds, g, S, E); }
        GRID_BAR();
        { KArgsP pa = kargs(); PHASE_IDS
          ln_rows(layer == 0 ? pa->in[0] : (const float*)nullptr, WSP(bf16, WS_XB), WSP(bf16, WS_R2), pa->in[16] + layer * D, pa->in[17] + layer * D, (float*)nullptr, WSP(bf16, WS_XB), gw, ngw, lane); }
        GRID_BAR();
        { KArgsP pa = kargs(); PHASE_IDS
          pg8::Gemm g{WSP(bf16, WS_XB), layer == 0 ? WSP(bf16, WS_WIN0) : WSP(bf16, WS_WIN1), M, DFF2, 1024, 1024, 1024}; pg8::StaticOrder S; S.init(M, DFF2, G, bid);
          pg8::EpiFfn1 E{WSP(bf16, WS_R1), WSP(bf16, WS_R4), pa->in[13] + (size_t)layer * 3 * DFF2, pa->in[14] + (size_t)layer * DFF2};
          pg8::gemm_phase<pg8::EpiFfn1, pg8::StaticOrder, true, true>(lds, g, S, E); }
        GRID_BAR();
        {
            KArgsP pa = kargs(); PHASE_IDS
            const float* cw = pa->in[13] + (size_t)layer * 3 * DFF2; const float* cb = pa->in[14] + (size_t)layer * DFF2; const bf16* UE = WSP(bf16, WS_R4); bf16* R1 = WSP(bf16, WS_R1);
            for (int it = gtid; it < 512 * 2 * 352; it += gthreads) {
                const int ch = it % 352, rr = (it / 352) & 1, blk = it / 704, f = ch * 8; const bool first = (blk & 31) == 0;
                float cc[2][8];
#pragma unroll
                for (int bj = 0; bj < 2; ++bj) {
                    const u32x4 z = (u32x4){0u, 0u, 0u, 0u};
                    const u32x4 u0 = *(const u32x4*)(UE + ((size_t)(blk * 4 + rr) * 2 + bj) * 2816 + f);
                    const u32x4 u1 = rr == 1 ? *(const u32x4*)(UE + ((size_t)(blk * 4 + 0) * 2 + bj) * 2816 + f) : (first ? z : *(const u32x4*)(UE + ((size_t)((blk - 1) * 4 + 3) * 2 + bj) * 2816 + f));
                    const u32x4 u2 = first ? z : *(const u32x4*)(UE + ((size_t)((blk - 1) * 4 + (rr == 1 ? 3 : 2)) * 2 + bj) * 2816 + f);
                    const float* w0 = cw + bj * 2816 + f; const float* w1 = w0 + 5632; const float* w2 = w1 + 5632; const float* bb = cb + bj * 2816 + f;
#pragma unroll
                    for (int e = 0; e < 4; ++e) {
                        cc[bj][2 * e] = bb[2 * e] + w2[2 * e] * bf_lo(u0[e]) + w1[2 * e] * bf_lo(u1[e]) + w0[2 * e] * bf_lo(u2[e]);
                        cc[bj][2 * e + 1] = bb[2 * e + 1] + w2[2 * e + 1] * bf_hi(u0[e]) + w1[2 * e + 1] * bf_hi(u1[e]) + w0[2 * e + 1] * bf_hi(u2[e]); }
                }
                u32x4 o; o.x = pk2(silu_mul(cc[0][0], cc[1][0]), silu_mul(cc[0][1], cc[1][1])); o.y = pk2(silu_mul(cc[0][2], cc[1][2]), silu_mul(cc[0][3], cc[1][3]));
                o.z = pk2(silu_mul(cc[0][4], cc[1][4]), silu_mul(cc[0][5], cc[1][5])); o.w = pk2(silu_mul(cc[0][6], cc[1][6]), silu_mul(cc[0][7], cc[1][7]));
                *(u32x4*)(R1 + (size_t)(64 * blk + rr) * 2816 + f) = o;
            }
        }
        GRID_BAR();
        { KArgsP pa = kargs(); PHASE_IDS
          pg8::Gemm g{WSP(bf16, WS_R1), layer == 0 ? WSP(bf16, WS_WOUT0) : WSP(bf16, WS_WOUT1), M, 1024, DFF, DFF, DFF}; pg8::StaticOrder S; S.init(M, 1024, G, bid);
          pg8::EpiBf16<0> E{WSP(bf16, WS_R5), 1024, nullptr, 0, 0, 1.f};
          pg8::gemm_phase<pg8::EpiBf16<0>, pg8::StaticOrder, true, true>(lds, g, S, E); }
        GRID_BAR();
        { KArgsP pa = kargs(); PHASE_IDS
          ln_rows((const float*)nullptr, WSP(bf16, WS_XB), WSP(bf16, WS_R5), pa->in[18] + layer * D, pa->in[19] + layer * D, layer == 0 ? (float*)nullptr : pa->out, layer == 0 ? WSP(bf16, WS_XB) : (bf16*)nullptr, gw, ngw, lane); }
        if (layer == 0) GRID_BAR();
    }
}

extern "C" void kernel_launch(void* const* d_in, const int* in_sizes, int n_in, void* d_out, int out_size, void* d_ws, size_t ws_size, hipStream_t stream) {
    static int grid = 0;
    if (grid == 0) {
        if (n_in != 20 || in_sizes[0] != M * D || out_size != M * D || ws_size < WS_END) { fprintf(stderr, "kernel_launch: unexpected shapes (n_in %d, in0 %d, out %d, ws %zu); nothing launched\n", n_in, n_in > 0 ? in_sizes[0] : -1, out_size, ws_size); grid = -1; return; }
        int dev = 0, cus = 0, per_cu = 0;
        if (hipGetDevice(&dev) != hipSuccess || hipDeviceGetAttribute(&cus, hipDeviceAttributeMultiprocessorCount, dev) != hipSuccess) { fprintf(stderr, "kernel_launch: device query failed\n"); grid = -1; return; }
        if (hipFuncSetAttribute((const void*)yoco_fwd, hipFuncAttributeMaxDynamicSharedMemorySize, LDS_BYTES) != hipSuccess) { fprintf(stderr, "kernel_launch: hipFuncSetAttribute failed\n"); grid = -1; return; }
        if (hipOccupancyMaxActiveBlocksPerMultiprocessor(&per_cu, (const void*)yoco_fwd, NTHREADS, LDS_BYTES) != hipSuccess || per_cu < 1) { fprintf(stderr, "kernel_launch: occupancy query says %d blocks per CU\n", per_cu); (void)hipGetLastError(); per_cu = 1; }
        grid = cus * 1;
    }
    if (grid < 0) return;
    Args a{};
    for (int i = 0; i < 20; ++i) a.in[i] = (const float*)d_in[i];
    a.out = (float*)d_out; a.ws = (unsigned char*)d_ws;
    void* kargs[] = {&a};
    const hipError_t e = hipLaunchCooperativeKernel((const void*)yoco_fwd, dim3(grid), dim3(NTHREADS), kargs, LDS_BYTES, stream);
    if (e != hipSuccess) fprintf(stderr, "kernel_launch: cooperative launch failed: %s (grid %d)\n", hipGetErrorString(e), grid);
}
```

```cpp
#include <hip/hip_runtime.h>
#include <hip/hip_cooperative_groups.h>
#include <cstdio>
#include <cstdint>
#include <cmath>
namespace cg = cooperative_groups;
namespace pg8 {
#define PG8_LAS __attribute__((address_space(3)))
typedef unsigned short bf16_t;
typedef short bf16x8 __attribute__((ext_vector_type(8)));
typedef float f32x4 __attribute__((ext_vector_type(4)));
typedef unsigned u32x4 __attribute__((ext_vector_type(4)));
constexpr int BM = 256, BK = 64, HALF = 128, HTB = HALF * BK * 2  , STAGE_BYTES = 8 * HTB, NXCD = 8, WGM = 8;

__host__ __device__ __forceinline__ int lds_byte(int r, int c) { const int st = (r >> 4) * 2 + (c >> 5), rr = r & 15, cc = c & 31, ob = rr * 64 + cc * 2; return st * 1024 + (ob ^ (((ob >> 9) & 1) << 5)); }
__host__ __device__ __forceinline__ void stage_rc(int b, int& R, int& C) { const int st = b / 1024, sb = b % 1024, swz = sb ^ (((sb >> 9) & 1) << 5); R = (st >> 1) * 16 + swz / 64; C = (st & 1) * 32 + (swz % 64) / 2; }
__host__ __device__ __forceinline__ int perm32(int rho) { const int n = rho >> 4, i = rho & 15; return 8 * (i >> 2) + 4 * n + (i & 3); }

__device__ __forceinline__ int pg8_ltid() { int t = threadIdx.x; asm volatile("" : "+v"(t)); return t; }
struct Unit { int pm, pn; };
struct Gemm { const bf16_t* A; const bf16_t* Bt; int M, N, K, lda, ldb; };

struct StaticOrder {
    int nM, nN, nwg, G, c;
    __host__ __device__ void init(int M, int N, int G_, int c_) { nM = M / BM; nN = N / BM; nwg = nM * nN; G = G_; c = c_; }
    __host__ __device__ bool next(int i, Unit& u) const {
        const long L = (long)i * G + c; if (L >= nwg) return false;
        int wgid = (int)L; { const int q = nwg / NXCD, r = nwg % NXCD, xcd = wgid % NXCD, off = wgid / NXCD; wgid = (xcd < r ? xcd * (q + 1) : r * (q + 1) + (xcd - r) * q) + off; }
        const int nig = WGM * nN, gid = wgid / nig, fm = gid * WGM, gsz = (nM - fm) < WGM ? (nM - fm) : WGM;
        u.pm = fm + ((wgid % nig) % gsz); u.pn = (wgid % nig) / gsz; return true;
    }
    __device__ __forceinline__ void a_ready(const Unit&) const {}
    __device__ __forceinline__ void done(const Unit&) const {}
};

__device__ __forceinline__ unsigned cvt_pk_bf16(float lo, float hi) { unsigned r; asm volatile("v_cvt_pk_bf16_f32 %0, %1, %2" : "=v"(r) : "v"(lo), "v"(hi)); return r; }
typedef float f32x2 __attribute__((ext_vector_type(2)));
__device__ __forceinline__ f32x2 gelu_pk(f32x2 v) {
    const f32x2 av = __builtin_elementwise_abs(v), d = av * 0.2316418882f + 1.0f;
    f32x2 t; t.x = __builtin_amdgcn_rcpf(d.x); t.y = __builtin_amdgcn_rcpf(d.y);
    f32x2 q = t * 0.5307027145f + (-0.7265760135f); q = q * t + 0.7107068705f; q = q * t + (-0.142248368f); q = q * t + 0.127414796f; q = q * t;
    const f32x2 s = (v * v) * (-0.72134752044f);
    f32x2 e; e.x = __builtin_amdgcn_exp2f(s.x); e.y = __builtin_amdgcn_exp2f(s.y);
    const f32x2 m = v * (q * e), r = v - m;
    f32x2 o; o.x = v.x < 0.f ? m.x : r.x; o.y = v.y < 0.f ? m.y : r.y; return o;
}

template <int ACT  > struct EpiBf16 {
    static constexpr bool PERM = true, AFTER_DRAIN = false; static_assert(ACT == 0 || ACT == 1, "EpiBf16: ACT is 0 (none) or 1 (gelu_pk)");
    bf16_t* O; int ldc; const float* bias; int split_cols; size_t split_stride; float scale0;
    __device__ __forceinline__ void operator()(const f32x4 (&acc)[2][2][4][2], const Unit& u, int wr, int wc, int fr, int fq) const {
        const int row0 = u.pm * BM + wr * 64 + fr; int colt = u.pn * BM; bf16_t* base = O;
        float sc = 1.f; if (split_cols) { const int t = colt / split_cols; base += (size_t)t * split_stride; colt -= t * split_cols; if (t == 0) sc = scale0; }
        const int col0 = colt + wc * 32 + 8 * fq, bcol0 = u.pn * BM + wc * 32 + 8 * fq;
        f32x4 bv[2][2];
#pragma unroll
        for (int bj = 0; bj < 2; ++bj)
#pragma unroll
            for (int n = 0; n < 2; ++n) bv[bj][n] = bias ? *(const f32x4*)(bias + bcol0 + bj * HALF + 4 * n) : (f32x4){0.f, 0.f, 0.f, 0.f};
#pragma unroll
        for (int ai = 0; ai < 2; ++ai)
#pragma unroll
            for (int m = 0; m < 4; ++m) { bf16_t* rowp = base + (size_t)(row0 + ai * HALF + m * 16) * ldc + col0;
#pragma unroll
                for (int bj = 0; bj < 2; ++bj) { f32x4 v0 = acc[ai][bj][m][0] + bv[bj][0], v1 = acc[ai][bj][m][1] + bv[bj][1];
                    if (ACT == 1) { f32x2 a = gelu_pk((f32x2){v0[0], v0[1]}), b = gelu_pk((f32x2){v0[2], v0[3]}), c = gelu_pk((f32x2){v1[0], v1[1]}), d = gelu_pk((f32x2){v1[2], v1[3]});
                        v0 = (f32x4){a.x, a.y, b.x, b.y}; v1 = (f32x4){c.x, c.y, d.x, d.y}; }
                    v0 = v0 * sc; v1 = v1 * sc; u32x4 w; w.x = cvt_pk_bf16(v0[0], v0[1]); w.y = cvt_pk_bf16(v0[2], v0[3]); w.z = cvt_pk_bf16(v1[0], v1[1]); w.w = cvt_pk_bf16(v1[2], v1[3]);
                    *(u32x4*)(rowp + bj * HALF) = w; } }
    }
};
typedef unsigned u32x2 __attribute__((ext_vector_type(2)));
struct EpiMla {
    static constexpr bool PERM = true, AFTER_DRAIN = false;
    bf16_t* O; int ldc; int split_cols; size_t split_stride; const float* rs; int rsi; float cscale; const float* rope; int qmode; float invk;
    __device__ __forceinline__ void operator()(const f32x4 (&acc)[2][2][4][2], const Unit& u, int wr, int wc, int fr, int fq) const {
        const int row0 = u.pm * BM + wr * 64 + fr; int colt = u.pn * BM; bf16_t* base = O;
        if (split_cols) { const int t = colt / split_cols; base += (size_t)t * split_stride; colt -= t * split_cols; }
        const int col0 = colt + wc * 32 + 8 * fq;
#pragma unroll
        for (int ai = 0; ai < 2; ++ai)
#pragma unroll
            for (int m = 0; m < 4; ++m) { const int row = row0 + ai * HALF + m * 16; const float s = __builtin_amdgcn_rsqf(rs[row * 2 + rsi] * invk + 1e-6f) * cscale; const int bb_ = row >> 11, tok_ = row & 2047;
#pragma unroll
                for (int bj = 0; bj < 2; ++bj) { f32x4 v0 = acc[ai][bj][m][0] * s, v1 = acc[ai][bj][m][1] * s;
                    if (qmode) { const int o = (col0 + bj * HALF) % 96;
                        if (o >= 64) { const int i0 = (o - 64) >> 1; const int t = row & 2047; const f32x4* tb = (const f32x4*)(rope + ((size_t)t * 16 + i0) * 2); const f32x4 c0 = tb[0], c1 = tb[1];
                            float a, b;
                            a = v0[0]; b = v0[1]; v0[0] = a * c0[0] - b * c0[1]; v0[1] = b * c0[0] + a * c0[1];
                            a = v0[2]; b = v0[3]; v0[2] = a * c0[2] - b * c0[3]; v0[3] = b * c0[2] + a * c0[3];
                            a = v1[0]; b = v1[1]; v1[0] = a * c1[0] - b * c1[1]; v1[1] = b * c1[0] + a * c1[1];
                            a = v1[2]; b = v1[3]; v1[2] = a * c1[2] - b * c1[3]; v1[3] = b * c1[2] + a * c1[3]; } }
                    u32x4 w; w.x = cvt_pk_bf16(v0[0], v0[1]); w.y = cvt_pk_bf16(v0[2], v0[3]); w.z = cvt_pk_bf16(v1[0], v1[1]); w.w = cvt_pk_bf16(v1[2], v1[3]);
                    { const int col = col0 + bj * HALF; const int hh_ = col / ldc, dd_ = col - hh_ * ldc; *(u32x4*)(base + ((size_t)(bb_ * 16 + hh_) * 2048 + tok_) * ldc + dd_) = w; } } }
    }
};
struct EpiQKV {
    static constexpr bool PERM = true, AFTER_DRAIN = false;
    bf16_t* O; size_t t_stride; float scale0;
    __device__ __forceinline__ void operator()(const f32x4 (&acc)[2][2][4][2], const Unit& u, int wr, int wc, int fr, int fq) const {
        const int row0 = u.pm * BM + wr * 64 + fr; const int colt = u.pn * BM; const int t = colt >> 10; bf16_t* base = O + (size_t)t * t_stride; const float sc = t == 0 ? scale0 : 1.f;
        const int cc0 = (colt & 1023) + wc * 32 + 8 * fq;
#pragma unroll
        for (int ai = 0; ai < 2; ++ai)
#pragma unroll
            for (int m = 0; m < 4; ++m) { const int row = row0 + ai * HALF + m * 16; const int bb_ = row >> 11, tok_ = row & 2047;
#pragma unroll
                for (int bj = 0; bj < 2; ++bj) { const int cc = cc0 + bj * HALF; const int hh_ = cc >> 6, dd_ = cc & 63;
                    const f32x4 v0 = acc[ai][bj][m][0] * sc, v1 = acc[ai][bj][m][1] * sc;
                    u32x4 w; w.x = cvt_pk_bf16(v0[0], v0[1]); w.y = cvt_pk_bf16(v0[2], v0[3]); w.z = cvt_pk_bf16(v1[0], v1[1]); w.w = cvt_pk_bf16(v1[2], v1[3]);
                    *(u32x4*)(base + ((size_t)(bb_ * 16 + hh_) * 2048 + tok_) * 64 + dd_) = w; } }
    }
};
struct EpiLat {
    static constexpr bool PERM = true, AFTER_DRAIN = false;
    bf16_t* O; float* ss; const float* rope; bf16_t* KR;
    __device__ __forceinline__ void operator()(const f32x4 (&acc)[2][2][4][2], const Unit& u, int wr, int wc, int fr, int fq) const {
        const int row0 = u.pm * BM + wr * 64 + fr; const int col0 = u.pn * BM + wc * 32 + 8 * fq;
#pragma unroll
        for (int ai = 0; ai < 2; ++ai)
#pragma unroll
            for (int m = 0; m < 4; ++m) { const int row = row0 + ai * HALF + m * 16; bf16_t* rowp = O + (size_t)row * 768 + col0; float sq = 0.f;
#pragma unroll
                for (int bj = 0; bj < 2; ++bj) { const f32x4 v0 = acc[ai][bj][m][0], v1 = acc[ai][bj][m][1];
                    u32x4 w; w.x = cvt_pk_bf16(v0[0], v0[1]); w.y = cvt_pk_bf16(v0[2], v0[3]); w.z = cvt_pk_bf16(v1[0], v1[1]); w.w = cvt_pk_bf16(v1[2], v1[3]);
                    *(u32x4*)(rowp + bj * HALF) = w;
                    if (u.pn < 2 || bj == 0) sq += (v0[0] * v0[0] + v0[1] * v0[1]) + (v0[2] * v0[2] + v0[3] * v0[3]) + (v1[0] * v1[0] + v1[1] * v1[1]) + (v1[2] * v1[2] + v1[3] * v1[3]);
                    else if (wc == 0) {
                        const int t = row & 2047; const f32x4* tb = (const f32x4*)(rope + ((size_t)t * 16 + 4 * fq) * 2); const f32x4 c0 = tb[0], c1 = tb[1];
                        u32x4 k; k.x = cvt_pk_bf16(v0[0] * c0[0] - v0[1] * c0[1], v0[1] * c0[0] + v0[0] * c0[1]); k.y = cvt_pk_bf16(v0[2] * c0[2] - v0[3] * c0[3], v0[3] * c0[2] + v0[2] * c0[3]);
                        k.z = cvt_pk_bf16(v1[0] * c1[0] - v1[1] * c1[1], v1[1] * c1[0] + v1[0] * c1[1]); k.w = cvt_pk_bf16(v1[2] * c1[2] - v1[3] * c1[3], v1[3] * c1[2] + v1[2] * c1[3]);
                        *(u32x4*)(KR + (size_t)row * 32 + 8 * fq) = k; } }
                sq += __shfl_xor(sq, 16); sq += __shfl_xor(sq, 32);
                if (fq == 0) atomicAdd(ss + row * 2 + (u.pn == 0 ? 0 : 1), sq); }
    }
};
struct EpiFfn1 {
    static constexpr bool PERM = true, AFTER_DRAIN = false;
    bf16_t* H; bf16_t* UE; const float* cw; const float* cb;
    __device__ __forceinline__ void operator()(const f32x4 (&acc)[2][2][4][2], const Unit& u, int wr, int wc, int fr, int fq) const {
        const int f0 = u.pn * 128 + wc * 32 + 8 * fq;
        u32x2 hold[8];
#pragma unroll
        for (int n = 0; n < 2; ++n) {
            const int f = f0 + 4 * n;
            f32x4 w[2][3], bb[2];
#pragma unroll
            for (int bj = 0; bj < 2; ++bj) {
#pragma unroll
                for (int j = 0; j < 3; ++j) w[bj][j] = *(const f32x4*)(cw + j * 5632 + bj * 2816 + f);
                bb[bj] = *(const f32x4*)(cb + bj * 2816 + f); }
#pragma unroll
            for (int ai = 0; ai < 2; ++ai) {
                const int blk = 4 * u.pm + 2 * ai + wr;
#pragma unroll
                for (int m = 0; m < 4; ++m) {
                    f32x4 c[2];
#pragma unroll
                    for (int bj = 0; bj < 2; ++bj) {
                        const f32x4 X = acc[ai][bj][m][n]; f32x4 p1, p2;
#pragma unroll
                        for (int e = 0; e < 4; ++e) {
                            const float xe = X[e]; const int xi = __builtin_bit_cast(int, xe);
                            int b1 = 0, b2 = 0;
                            if (m > 0) { const float pe = acc[ai][bj][m > 0 ? m - 1 : 0][n][e]; const int pi = __builtin_bit_cast(int, pe);
                                b1 = __builtin_amdgcn_update_dpp(0, pi, 0x10F, 0xf, 0xf, true); b2 = __builtin_amdgcn_update_dpp(0, pi, 0x10E, 0xf, 0xf, true); }
                            p1[e] = __builtin_bit_cast(float, __builtin_amdgcn_update_dpp(b1, xi, 0x111, 0xf, 0xf, false));
                            p2[e] = __builtin_bit_cast(float, __builtin_amdgcn_update_dpp(b2, xi, 0x112, 0xf, 0xf, false)); }
                        c[bj] = bb[bj] + w[bj][2] * X + w[bj][1] * p1 + w[bj][0] * p2;
                        if (m == 0 && fr < 2) { u32x2 t; t.x = cvt_pk_bf16(X[0], X[1]); t.y = cvt_pk_bf16(X[2], X[3]); *(u32x2*)(UE + ((size_t)(blk * 4 + fr) * 2 + bj) * 2816 + f) = t; }
                        if (m == 3 && fr >= 14) { u32x2 t; t.x = cvt_pk_bf16(X[0], X[1]); t.y = cvt_pk_bf16(X[2], X[3]); *(u32x2*)(UE + ((size_t)(blk * 4 + 2 + (fr - 14)) * 2 + bj) * 2816 + f) = t; }
                    }
                    f32x4 hv;
#pragma unroll
                    for (int e = 0; e < 4; ++e) { const float g = c[0][e]; hv[e] = g * __builtin_amdgcn_rcpf(1.0f + __expf(-g)) * c[1][e]; }
                    const int row = u.pm * BM + ai * HALF + wr * 64 + m * 16 + fr;
                    u32x2 t; t.x = cvt_pk_bf16(hv[0], hv[1]); t.y = cvt_pk_bf16(hv[2], hv[3]);
                    if (n == 0) hold[ai * 4 + m] = t;
                    else { u32x4 w4; w4.x = hold[ai * 4 + m].x; w4.y = hold[ai * 4 + m].y; w4.z = t.x; w4.w = t.y; *(u32x4*)(H + (size_t)row * 2816 + f0) = w4; }
                }
            }
        }
    }
};
template <class Epi, class Sched, bool ALIGN_EPI = false, bool SP2 = false>
__device__ __forceinline__ void gemm_phase(PG8_LAS unsigned char* lds, const Gemm g, const Sched& S, const Epi& E) {
    const int tid = pg8_ltid(), wid = __builtin_amdgcn_readfirstlane(tid >> 6), lane = tid & 63, wr = wid >> 2, wc = wid & 3, fr = lane & 15, fq = lane >> 4;
    const int K = g.K, nt = K / BK;
    unsigned voffA[2], voffB[2];
#pragma unroll
    for (int i = 0; i < 2; ++i) { int R, C; stage_rc(tid * 16 + i * 8192, R, C); const int Rb = Epi::PERM ? ((R & ~31) + perm32(R & 31)) : R;
        voffA[i] = (unsigned)(R * g.lda + C) * 2u; voffB[i] = (unsigned)(Rb * g.ldb + C) * 2u; }
    const size_t kstep = (size_t)(BK * 2);
    const size_t hstepA = (size_t)HALF * g.lda * 2, hstepB = (size_t)HALF * g.ldb * 2;
    const size_t tstepA = 2 * hstepA, tstepB = 2 * hstepB;
    const unsigned ldsw = (unsigned)wid * 1024u;
    const int aoff = lds_byte(wr * 64 + fr, fq * 8), boff = lds_byte(wc * 32 + fr, fq * 8);
#define PG8_SA(b, h) (((b) * 2 + (h)) * HTB)
#define PG8_SB(b, h) ((4 + (b) * 2 + (h)) * HTB)
#define PG8_STAGE(bufoff, gbase, voff) do { _Pragma("unroll") for (int _i = 0; _i < 2; ++_i) \
        __builtin_amdgcn_global_load_lds((const unsigned*)((const char*)(gbase) + (voff)[_i]), (PG8_LAS unsigned*)(lds + (bufoff) + ldsw + _i * 8192), 16, 0, 0); } while (0)
#define PG8_LDA(dst, b, h) do { _Pragma("unroll") for (int m = 0; m < 4; ++m) _Pragma("unroll") for (int k = 0; k < 2; ++k) dst[m][k] = *(const PG8_LAS bf16x8*)(lds + PG8_SA(b, h) + aoff + m * 2048 + k * 1024); } while (0)
#define PG8_LDB(dst, b, h) do { _Pragma("unroll") for (int n = 0; n < 2; ++n) _Pragma("unroll") for (int k = 0; k < 2; ++k) dst[n][k] = *(const PG8_LAS bf16x8*)(lds + PG8_SB(b, h) + boff + n * 2048 + k * 1024); } while (0)
#define PG8_MMA(ai, bj, At, Bt) do { __builtin_amdgcn_s_setprio(1); _Pragma("unroll") for (int m = 0; m < 4; ++m) _Pragma("unroll") for (int n = 0; n < 2; ++n) _Pragma("unroll") for (int k = 0; k < 2; ++k) \
        acc[ai][bj][m][n] = __builtin_amdgcn_mfma_f32_16x16x32_bf16(Bt[n][k], At[m][k], acc[ai][bj][m][n], 0, 0, 0); __builtin_amdgcn_s_setprio(0); } while (0)
#define PG8_WAIT_V(n) asm volatile("s_waitcnt vmcnt(" #n ")" ::: "memory")
#define PG8_WAIT_L(n) asm volatile("s_waitcnt lgkmcnt(" #n ")" ::: "memory")
#define PG8_BAR __builtin_amdgcn_s_barrier()
#define PG8_SCHED __builtin_amdgcn_sched_barrier(0)
    Unit cur, nxt; int ui = 0;
    if (!S.next(0, cur)) return;
    f32x4 acc[2][2][4][2];
#pragma unroll
    for (int a = 0; a < 2; ++a)
#pragma unroll
        for (int b = 0; b < 2; ++b)
#pragma unroll
            for (int m = 0; m < 4; ++m)
#pragma unroll
                for (int n = 0; n < 2; ++n) acc[a][b][m][n] = (f32x4){0.f, 0.f, 0.f, 0.f};
    bf16x8 At[4][2], B0[2][2], B1[2][2];
    const char* cA = (const char*)g.A + (size_t)cur.pm * tstepA; const char* cB = (const char*)g.Bt + (size_t)cur.pn * tstepB;
    S.a_ready(cur);
    if constexpr (SP2) {
        PG8_STAGE(PG8_SB(0, 0), cB, voffB); PG8_STAGE(PG8_SB(0, 1), cB + hstepB, voffB); PG8_STAGE(PG8_SA(0, 0), cA, voffA); PG8_STAGE(PG8_SA(0, 1), cA + hstepA, voffA);
        if (wr == 1) PG8_BAR;
        PG8_WAIT_V(2); PG8_BAR;
        PG8_STAGE(PG8_SB(1, 0), cB + kstep, voffB); PG8_STAGE(PG8_SA(1, 0), cA + kstep, voffA); PG8_STAGE(PG8_SB(1, 1), cB + hstepB + kstep, voffB);
        PG8_WAIT_V(6); PG8_BAR;
    } else {
        PG8_STAGE(PG8_SB(0, 0), cB, voffB); PG8_STAGE(PG8_SA(0, 0), cA, voffA); PG8_STAGE(PG8_SB(0, 1), cB + hstepB, voffB); PG8_STAGE(PG8_SA(0, 1), cA + hstepA, voffA);
        if (wr == 1) PG8_BAR;
        PG8_WAIT_V(4); PG8_BAR;
        PG8_STAGE(PG8_SB(1, 0), cB + kstep, voffB); PG8_STAGE(PG8_SA(1, 0), cA + kstep, voffA); PG8_STAGE(PG8_SB(1, 1), cB + hstepB + kstep, voffB);
        PG8_WAIT_V(6); PG8_BAR;
    }
    for (;;) {
        const bool has_next = S.next(ui + 1, nxt);
        const char* nA = has_next ? (const char*)g.A + (size_t)nxt.pm * tstepA : cA; const char* nB = has_next ? (const char*)g.Bt + (size_t)nxt.pn * tstepB : cB;
        for (int t = 0; t < nt; t += 2) {
            const bool last = (t == nt - 2);
            const char* a1 = cA + (size_t)(t + 1) * kstep;
            const char* a2 = last ? nA : cA + (size_t)(t + 2) * kstep; const char* b2 = last ? nB : cB + (size_t)(t + 2) * kstep;
            const char* a3 = a2 + kstep; const char* b3 = b2 + kstep;
            if (last && has_next) S.a_ready(nxt);
            if constexpr (SP2) {
            PG8_LDB(B0, 0, 0); PG8_LDB(B1, 0, 1); PG8_SCHED; PG8_LDA(At, 0, 0); PG8_STAGE(PG8_SA(1, 1), a1 + hstepA, voffA);
            PG8_WAIT_V(8); PG8_WAIT_L(0); PG8_BAR; PG8_MMA(0, 0, At, B0); PG8_MMA(0, 1, At, B1); PG8_BAR; PG8_SCHED;
            PG8_LDA(At, 0, 1); PG8_STAGE(PG8_SB(0, 0), b2, voffB); PG8_STAGE(PG8_SB(0, 1), b2 + hstepB, voffB); PG8_STAGE(PG8_SA(0, 0), a2, voffA);
            PG8_WAIT_V(8); PG8_WAIT_L(0); PG8_BAR; PG8_MMA(1, 0, At, B0); PG8_MMA(1, 1, At, B1); PG8_BAR; PG8_SCHED;
            PG8_LDB(B0, 1, 0); PG8_LDB(B1, 1, 1); PG8_SCHED; PG8_LDA(At, 1, 0); PG8_STAGE(PG8_SA(0, 1), a2 + hstepA, voffA);
            PG8_WAIT_V(8); PG8_WAIT_L(0); PG8_BAR; PG8_MMA(0, 0, At, B0); PG8_MMA(0, 1, At, B1); PG8_BAR; PG8_SCHED;
            PG8_LDA(At, 1, 1); PG8_STAGE(PG8_SB(1, 0), b3, voffB); PG8_STAGE(PG8_SB(1, 1), b3 + hstepB, voffB); PG8_STAGE(PG8_SA(1, 0), a3, voffA);
            PG8_WAIT_V(8); PG8_WAIT_L(0); PG8_BAR; PG8_MMA(1, 0, At, B0); PG8_MMA(1, 1, At, B1); PG8_BAR; PG8_SCHED;
            } else {
            PG8_LDB(B0, 0, 0); PG8_SCHED; PG8_LDA(At, 0, 0); PG8_STAGE(PG8_SA(1, 1), a1 + hstepA, voffA);
            PG8_WAIT_L(8); PG8_BAR; PG8_WAIT_L(0); PG8_MMA(0, 0, At, B0); PG8_BAR; PG8_SCHED;
            PG8_LDB(B1, 0, 1); PG8_STAGE(PG8_SB(0, 0), b2, voffB);
            PG8_BAR; PG8_WAIT_L(0); PG8_MMA(0, 1, At, B1); PG8_BAR;
            PG8_LDA(At, 0, 1); PG8_STAGE(PG8_SA(0, 0), a2, voffA);
            PG8_BAR; PG8_WAIT_L(0); PG8_MMA(1, 0, At, B0); PG8_BAR; PG8_SCHED;
            PG8_STAGE(PG8_SB(0, 1), b2 + hstepB, voffB);
            PG8_WAIT_V(6); PG8_BAR; PG8_MMA(1, 1, At, B1); PG8_BAR;
            PG8_LDB(B0, 1, 0); PG8_SCHED; PG8_LDA(At, 1, 0); PG8_STAGE(PG8_SA(0, 1), a2 + hstepA, voffA);
            PG8_WAIT_L(8); PG8_BAR; PG8_WAIT_L(0); PG8_MMA(0, 0, At, B0); PG8_BAR; PG8_SCHED;
            PG8_LDB(B1, 1, 1); PG8_STAGE(PG8_SB(1, 0), b3, voffB);
            PG8_BAR; PG8_WAIT_L(0); PG8_MMA(0, 1, At, B1); PG8_BAR;
            PG8_LDA(At, 1, 1); PG8_STAGE(PG8_SA(1, 0), a3, voffA);
            PG8_BAR; PG8_WAIT_L(0); PG8_MMA(1, 0, At, B0); PG8_BAR; PG8_SCHED;
            PG8_STAGE(PG8_SB(1, 1), b3 + hstepB, voffB);
            PG8_WAIT_V(6); PG8_BAR; PG8_MMA(1, 1, At, B1); PG8_BAR;
            }
        }
        if constexpr (ALIGN_EPI) { if (wr == 0) PG8_BAR; }
        if constexpr (!Epi::AFTER_DRAIN) { E(acc, cur, wr, wc, fr, fq); S.done(cur); }
        if (!has_next) break;
#pragma unroll
        for (int a = 0; a < 2; ++a)
#pragma unroll
            for (int b = 0; b < 2; ++b)
#pragma unroll
                for (int m = 0; m < 4; ++m)
#pragma unroll
                    for (int n = 0; n < 2; ++n) acc[a][b][m][n] = (f32x4){0.f, 0.f, 0.f, 0.f};
        cur = nxt; cA = nA; cB = nB; ++ui;
        if constexpr (ALIGN_EPI) { if (wr == 1) PG8_BAR; }
    }
    PG8_WAIT_V(0);
    if constexpr (!ALIGN_EPI) { if (wr == 0) PG8_BAR; }
    PG8_BAR;
    if constexpr (Epi::AFTER_DRAIN) { E.fused(acc, cur, wr, wc, fr, fq, lds, wid, lane); S.done(cur); }
#undef PG8_SA
#undef PG8_SB
#undef PG8_STAGE
#undef PG8_LDA
#undef PG8_LDB
#undef PG8_MMA
#undef PG8_WAIT_V
#undef PG8_WAIT_L
#undef PG8_BAR
#undef PG8_SCHED
}
}
#define LAS __attribute__((address_space(3)))
typedef unsigned short bf16;
typedef short bf16x8 __attribute__((ext_vector_type(8)));
typedef float f32x4 __attribute__((ext_vector_type(4)));
typedef float f32x16 __attribute__((ext_vector_type(16)));
typedef unsigned u32x4 __attribute__((ext_vector_type(4)));
typedef unsigned u32x2 __attribute__((ext_vector_type(2)));
typedef short v4i16_t __attribute__((ext_vector_type(4)));
constexpr int NWAVES = 8, NTHREADS = 512;
constexpr int SEQ = 2048, BATCH = 16, M = BATCH * SEQ, D = 1024, NH = 16, DFF = 2816, DFF2 = 5632;
constexpr int NLAT = 768, KVR = 256, QR = 384, NQ = 1536;
constexpr float ALPHA = 1.4142135623730951f;
constexpr float LN_EPS = 1e-5f, RMS_EPS = 1e-6f;
constexpr float LOG2E = 1.4426950408889634f;
constexpr size_t MiB = 1u << 20;
constexpr size_t WS_ROPE = 1 * MiB;
constexpr size_t WS_WQKV = 2 * MiB, WS_WOA = 8 * MiB, WS_WLAT = 10 * MiB, WS_WUKV = 12 * MiB, WS_WUQ = 13 * MiB, WS_WOB = 15 * MiB;
constexpr size_t WS_WIN0 = 17 * MiB, WS_WIN1 = 28 * MiB, WS_WOUT0 = 39 * MiB, WS_WOUT1 = 39 * MiB + 5632 * 1024, WS_WEND = 50 * MiB;
constexpr size_t WS_RS = 52 * MiB;
constexpr size_t WS_KR = 53 * MiB;
constexpr size_t WS_LSE = 56 * MiB;
constexpr size_t WS_XB = 62 * MiB;
constexpr size_t WS_SP = 64 * MiB + 272 * 1024;
constexpr size_t WS_R1 = WS_XB + WS_SP, WS_R2 = WS_R1 + WS_SP, WS_R3 = WS_R2 + WS_SP, WS_R4 = WS_R3 + WS_SP, WS_R5 = WS_R4 + WS_SP, WS_R6 = WS_R5 + WS_SP, WS_END = 512 * MiB;
static_assert(WS_R6 + 64 * MiB <= WS_END && WS_R1 + (size_t)32768 * 2816 * 2 <= WS_R4 && WS_R4 + (size_t)32768 * 1536 * 2 <= WS_R6 + 64 * MiB, "d_ws map");
constexpr int LDS_OST = 104448, OST_WAVE = 32 * 144;
constexpr int LDS_MISC = LDS_OST + 8 * OST_WAVE;
constexpr int LDS_BYTES = LDS_MISC + 2048;

__device__ __forceinline__ unsigned f2bf(float f) { unsigned u = __builtin_bit_cast(unsigned, f); return (u + 0x7fffu + ((u >> 16) & 1u)) >> 16; }
__device__ __forceinline__ unsigned pk2(float lo, float hi) { return f2bf(lo) | (f2bf(hi) << 16); }
__device__ __forceinline__ float bf_lo(unsigned w) { return __builtin_bit_cast(float, w << 16); }
__device__ __forceinline__ float bf_hi(unsigned w) { return __builtin_bit_cast(float, w & 0xffff0000u); }
__device__ __forceinline__ float wave_sum(float v) {
#pragma unroll
    for (int o = 1; o < 64; o <<= 1) v += __shfl_xor(v, o);
    return v;
}
__device__ __forceinline__ float silu_mul(float g, float v) { return g * __builtin_amdgcn_rcpf(1.0f + __expf(-g)) * v; }

#define GAS __attribute__((address_space(1)))
typedef GAS unsigned gu32;
typedef GAS unsigned long long gu64;
#define RLX_AGENT __ATOMIC_RELAXED, __HIP_MEMORY_SCOPE_AGENT
#define LDS_WAIT() asm volatile("s_waitcnt lgkmcnt(0)" ::: "memory")
#define VM_WAIT() asm volatile("s_waitcnt vmcnt(0)" ::: "memory")
#define XB_TMO      128
#define XB_XCNT(j)  (256  + 64 * (j))
#define XB_XSUB(j)  (1280 + 64 * (j))
#define XB_XGEN(j)  (2304 + 64 * (j))
#define XB_TOP      3328
#define XB_TOPGEN   3392
#define XCD_BAR_WORDS 3456
#define XB_SPIN_CAP (1u << 18)

__device__ __forceinline__ unsigned xb_ld(unsigned* p)              { return __hip_atomic_load(p, __ATOMIC_RELAXED, __HIP_MEMORY_SCOPE_AGENT); }
__device__ __forceinline__ unsigned xb_add(unsigned* p, unsigned v) { return __hip_atomic_fetch_add(p, v, __ATOMIC_RELAXED, __HIP_MEMORY_SCOPE_AGENT); }
__device__ __forceinline__ unsigned xb_xcc_id() { return (unsigned)__builtin_amdgcn_s_getreg((3 << 11) | 20) & 0xFu; }
#define XB_SPIN(cond, bar) do { unsigned _sp = 0; while (cond) { __builtin_amdgcn_s_sleep(1); \
    if ((++_sp & 255u) == 0u) { if (xb_ld(&(bar)[XB_TMO])) break; if (_sp > XB_SPIN_CAP) { atomicAdd(&(bar)[XB_TMO], 1u); break; } } } } while (0)

struct XcdBarrier {
    unsigned* bar; unsigned x;
    volatile LAS unsigned* st;
};

__device__ __forceinline__ XcdBarrier xcd_barrier_post(unsigned* bar, volatile LAS unsigned* st) {
    XcdBarrier b; b.bar = bar; b.x = xb_xcc_id(); b.st = st;
    if (threadIdx.x == 0) (void)xb_add(&bar[XB_XCNT(b.x)], 1u);
    return b;
}
__device__ __forceinline__ void xcd_barrier_complete(unsigned* bar, unsigned x, unsigned& nloc, unsigned& nx) {
    const unsigned G = gridDim.x * gridDim.y * gridDim.z;
    unsigned sum, cnt, mine, sp = 0u;
    for (;;) {
        sum = 0u; cnt = 0u; mine = 0u;
#pragma unroll
        for (unsigned j = 0; j < 16; ++j) { const unsigned c = xb_ld(&bar[XB_XCNT(j)]); sum += c; cnt += (c > 0u) ? 1u : 0u; mine = (j == x) ? c : mine; }
        if (sum == G) break;
        __builtin_amdgcn_s_sleep(1);
        if ((++sp & 255u) == 0u) { if (xb_ld(&bar[XB_TMO])) break; if (sp > XB_SPIN_CAP) { atomicAdd(&bar[XB_TMO], 1u); break; } }
    }
    nloc = mine > 0u ? mine : 1u; nx = cnt > 0u ? cnt : 1u;
}

__device__ __forceinline__ void xcd_barrier(const XcdBarrier& b) {
    asm volatile("s_waitcnt vmcnt(0)" ::: "memory");
    __syncthreads();
    if (threadIdx.x == 0) {
        unsigned* bar = b.bar;
        __builtin_amdgcn_s_waitcnt(0);
        unsigned nloc = b.st[0], nx = b.st[1];
        if (nloc == 0u) { xcd_barrier_complete(bar, b.x, nloc, nx); b.st[0] = nloc; b.st[1] = nx; }
        const unsigned old = xb_add(&bar[XB_XSUB(b.x)], 1u);
        const unsigned gen = old / nloc;
        if (old + 1u == (gen + 1u) * nloc) {
            __builtin_amdgcn_fence(__ATOMIC_RELEASE, "agent");
            asm volatile("s_waitcnt vmcnt(0)" ::: "memory");
            const unsigned og = xb_add(&bar[XB_TOP], 1u);
            const unsigned tg = og / nx;
            if (og + 1u == (tg + 1u) * nx) xb_add(&bar[XB_TOPGEN], 1u);
            else XB_SPIN(xb_ld(&bar[XB_TOPGEN]) == tg, bar);
            __builtin_amdgcn_fence(__ATOMIC_ACQUIRE, "agent");
            xb_add(&bar[XB_XGEN(b.x)], 1u);
            asm volatile("s_waitcnt vmcnt(0)" ::: "memory");
        } else {
            XB_SPIN(xb_ld(&bar[XB_XGEN(b.x)]) == gen, bar);
            __builtin_amdgcn_fence(__ATOMIC_ACQUIRE, "agent");
            asm volatile("s_waitcnt vmcnt(0)" ::: "memory");
        }
    }
    __syncthreads();
}


constexpr size_t WS_BAR = 0;
#define GRID_BAR() do { XcdBarrier b_; b_.bar = (unsigned*)(kargs()->ws + WS_BAR); b_.x = xb_xcc_id(); b_.st = (volatile LAS unsigned*)(lds + LDS_MISC); xcd_barrier(b_); } while (0)

struct PrepSrc { const float* p0; const float* p1; const float* p2; const float* gain; };
template <int MODE> __device__ __forceinline__ void prep_item(const PrepSrc S, int K, int N, bf16* WT, LAS float* scr, int item, int lane) {
    const int nblk = N / 32, kb = item / nblk, nb = item % nblk, k0 = 64 * kb, n0 = 32 * nb;
    const int cq = lane & 7, nq = n0 + 4 * cq;
    const float* cp = nullptr; int ld = 0; bool pairs = false;
    if (MODE == 0) { cp = S.p0 + nq; ld = N; }
    else if (MODE == 1) { if (nq < 256) { cp = S.p0 + nq; ld = 256; } else if (nq < 640) { cp = S.p1 + (nq - 256); ld = 384; } else if (nq < 672) { cp = S.p2 + ((nq - 640) >> 1); ld = 32; pairs = true; } }
    else if (MODE == 2) { if (nq < 1024) { cp = S.p0 + nq; } else { cp = S.p1 + (nq - 1024); } ld = 1024; }
    else if (MODE == 3) { const int h = nq / 96, o = nq % 96; if (o < 64) cp = S.p0 + h * 96 + o; else { cp = S.p0 + h * 96 + 64 + ((o - 64) >> 1); pairs = true; } ld = 1536; }
    else { const int pn = nq >> 8, o = nq & 255; const int f = 128 * pn + (o & 127); cp = S.p0 + ((o < 128) ? f : 2816 + f); ld = 5632; }
#pragma unroll
    for (int i = 0; i < 8; ++i) { const int kk = 8 * i + (lane >> 3); f32x4 v = (f32x4){0.f, 0.f, 0.f, 0.f};
        if (cp) { const float* rp = cp + (size_t)(k0 + kk) * ld;
            if (!pairs) v = __builtin_nontemporal_load((const f32x4*)rp);
            else { v[0] = rp[0]; v[1] = rp[16]; v[2] = rp[1]; v[3] = rp[17]; } }
        if (MODE == 2 || MODE == 3) v = v * S.gain[k0 + kk];
        LAS float* d = scr + kk * 33 + 4 * cq; d[0] = v[0]; d[1] = v[1]; d[2] = v[2]; d[3] = v[3]; }
    asm volatile("s_waitcnt lgkmcnt(0)" ::: "memory");
    const int c = lane & 7;
#pragma unroll
    for (int j = 0; j < 4; ++j) { const int nn = (lane >> 3) + 8 * j; const LAS float* s = scr + (8 * c) * 33 + nn;
        u32x4 o; o.x = pk2(s[0 * 33], s[1 * 33]); o.y = pk2(s[2 * 33], s[3 * 33]); o.z = pk2(s[4 * 33], s[5 * 33]); o.w = pk2(s[6 * 33], s[7 * 33]);
        *(u32x4*)(WT + (size_t)(n0 + nn) * K + k0 + 8 * c) = o; }
    asm volatile("s_waitcnt lgkmcnt(0)" ::: "memory");
}

__device__ __forceinline__ void ln_rows(const float* xin, const bf16* xinb, const bf16* add, const float* g, const float* b, float* xout, bf16* xb, int gw, int ngw, int lane) {
    constexpr int R = 4;
    f32x4 gv[4], bv[4];
#pragma unroll
    for (int j = 0; j < 4; ++j) { gv[j] = *((const f32x4*)g + lane + 64 * j); bv[j] = *((const f32x4*)b + lane + 64 * j); }
    for (int m0 = gw * R; m0 < M; m0 += ngw * R) {
        f32x4 v[R][4]; u32x2 av[R][4];
#pragma unroll
        for (int q = 0; q < R; ++q) { const int m = m0 + q;
            const u32x2* ar = (const u32x2*)(add + (size_t)m * D) + lane;
#pragma unroll
            for (int j = 0; j < 4; ++j) av[q][j] = __builtin_nontemporal_load(&ar[64 * j]);
            if (xin) { const f32x4* xr = (const f32x4*)(xin + (size_t)m * D) + lane;
#pragma unroll
                for (int j = 0; j < 4; ++j) v[q][j] = __builtin_nontemporal_load(&xr[64 * j]);
            } else { const u32x2* xr = (const u32x2*)(xinb + (size_t)m * D) + lane;
#pragma unroll
                for (int j = 0; j < 4; ++j) { const u32x2 x = __builtin_nontemporal_load(&xr[64 * j]); v[q][j][0] = bf_lo(x.x); v[q][j][1] = bf_hi(x.x); v[q][j][2] = bf_lo(x.y); v[q][j][3] = bf_hi(x.y); } } }
        float s[R], s2[R];
#pragma unroll
        for (int q = 0; q < R; ++q) { s[q] = 0.f; s2[q] = 0.f;
#pragma unroll
            for (int j = 0; j < 4; ++j) { const u32x2 a = av[q][j];
                v[q][j][0] = ALPHA * v[q][j][0] + bf_lo(a.x); v[q][j][1] = ALPHA * v[q][j][1] + bf_hi(a.x); v[q][j][2] = ALPHA * v[q][j][2] + bf_lo(a.y); v[q][j][3] = ALPHA * v[q][j][3] + bf_hi(a.y);
                s[q] += (v[q][j][0] + v[q][j][1]) + (v[q][j][2] + v[q][j][3]);
                s2[q] += (v[q][j][0] * v[q][j][0] + v[q][j][1] * v[q][j][1]) + (v[q][j][2] * v[q][j][2] + v[q][j][3] * v[q][j][3]); } }
#pragma unroll
        for (int o = 1; o < 64; o <<= 1) {
#pragma unroll
            for (int q = 0; q < R; ++q) { s[q] += __shfl_xor(s[q], o); s2[q] += __shfl_xor(s2[q], o); } }
#pragma unroll
        for (int q = 0; q < R; ++q) { const int m = m0 + q;
            const float mean = s[q] * (1.f / D); const float var = fmaxf(s2[q] * (1.f / D) - mean * mean, 0.f); const float rstd = 1.f / sqrtf(var + LN_EPS);
            f32x4* orow = xout ? (f32x4*)(xout + (size_t)m * D) + lane : nullptr; u32x2* brow = xb ? (u32x2*)(xb + (size_t)m * D) + lane : nullptr;
#pragma unroll
            for (int j = 0; j < 4; ++j) { const f32x4 o = (v[q][j] - mean) * rstd * gv[j] + bv[j];
                if (xout) __builtin_nontemporal_store(o, &orow[64 * j]);
                if (xb) { u32x2 w; w.x = pk2(o[0], o[1]); w.y = pk2(o[2], o[3]); brow[64 * j] = w; } } }
    }
}

__device__ __forceinline__ int crow(int r, int hi) { return (r & 3) + 8 * (r >> 2) + 4 * hi; }
__device__ __forceinline__ unsigned cvtpk(float lo, float hi) { typedef float f2 __attribute__((ext_vector_type(2))); typedef __bf16 b2 __attribute__((ext_vector_type(2))); f2 v = {lo, hi}; b2 b = __builtin_convertvector(v, b2); return __builtin_bit_cast(unsigned, b); }
typedef short s16x4 __attribute__((ext_vector_type(4)));
__device__ __forceinline__ float xhalf(float v) { const unsigned u = __float_as_uint(v); auto rr = __builtin_amdgcn_permlane32_swap(u, u, false, false); return __uint_as_float((threadIdx.x & 32) ? rr[0] : rr[1]); }
__device__ __forceinline__ s16x4 vtr(const LAS unsigned char* p) { return __builtin_bit_cast(s16x4, __builtin_amdgcn_ds_read_tr16_b64_v4i16((LAS v4i16_t*)p)); }

template <bool NT> __device__ __forceinline__ void store_o_rows(LAS unsigned char* stg, const f32x16 (&o)[2], float inv, bf16* Ohead, int tok0, int tokstep, int lane) {
    const int r32 = lane & 31, hi = lane >> 5;
#pragma unroll
    for (int db = 0; db < 2; ++db)
#pragma unroll
        for (int g = 0; g < 4; ++g) { u32x2 wv; wv.x = cvtpk(o[db][4 * g] * inv, o[db][4 * g + 1] * inv); wv.y = cvtpk(o[db][4 * g + 2] * inv, o[db][4 * g + 3] * inv);
            *(LAS u32x2*)(stg + r32 * 144 + (32 * db + 8 * g + 4 * hi) * 2) = wv; }
    asm volatile("s_waitcnt lgkmcnt(0)" ::: "memory");
#pragma unroll
    for (int i = 0; i < 4; ++i) { const int row = (lane >> 3) + 8 * i, ch = lane & 7; const u32x4 v = *(const LAS u32x4*)(stg + row * 144 + ch * 16);
        if (NT) __builtin_nontemporal_store(v, (u32x4*)(Ohead + (size_t)(tok0 + row * tokstep) * 1024 + ch * 8)); else *(u32x4*)(Ohead + (size_t)(tok0 + row * tokstep) * 1024 + ch * 8) = v; }
    asm volatile("s_waitcnt lgkmcnt(0)" ::: "memory");
}

template <int DQK> __device__ __forceinline__ void attn_unit(LAS unsigned char* lds, int mode, int b, int h, int blk, const bf16* Qp, int ldq, int qcol,
                                                            const bf16* Kp, const bf16* KRp, const bf16* Vp, bf16* Op, float* lsep) {
    constexpr int KSTR = DQK * 2 + 16, KBUF = 64 * KSTR, VBUF = 64 * 128, NKS = DQK / 16;
    const int tid = pg8::pg8_ltid(), lane = tid & 63, r32 = lane & 31, hi = lane >> 5; const int w = __builtin_amdgcn_readfirstlane(tid >> 6);
    LAS unsigned char* Kl = lds; LAS unsigned char* Vl = lds + 2 * KBUF;
    int d = 1, res = 0, qs0 = 0, ks0 = 0, nt = 4, qs_w, res_w, maxback = 128; float slope2 = 0.f;
    if (mode == 0) { qs0 = 256 * blk; nt = 4 * (blk + 1); maxback = 1 << 30; }
    else { const float sl = exp2f(-0.5f * (float)(h + 1)) * LOG2E;
        if (mode == 1) { qs0 = 256 * blk; ks0 = qs0 >= 128 ? qs0 - 128 : 0; nt = (qs0 + 256 - ks0) >> 6; slope2 = sl; }
        else if (mode == 2) { d = 4; res = blk >> 1; qs0 = 256 * (blk & 1); ks0 = qs0 >= 128 ? qs0 - 128 : 0; nt = (qs0 + 256 - ks0) >> 6; slope2 = sl * 4.f; }
        else { d = 16; nt = 4; slope2 = sl * 16.f; } }
    if (mode == 3) { qs_w = 32 * (w & 3); res_w = 2 * blk + (w >> 2); } else { qs_w = qs0 + 32 * w; res_w = res; }
    const int tokbase = b * SEQ;
    const int tq = tokbase + (qs_w + r32) * d + res_w;
    const int srow = tid >> 3, sch = tid & 7, rrow = (tid >> 2) & 63, rch = tid & 3;
    u32x4 kreg0, vreg0, rreg0, kreg1, vreg1, rreg1;
#define ATT_TOK(t, j) (mode == 3 ? tokbase + (32 * (t) + ((j) & 31)) * 16 + 2 * blk + ((j) >> 5) : tokbase + (ks0 + 64 * (t) + (j)) * d + res)
#define ATT_LOAD(S, t) do { const size_t tk = (size_t)ATT_TOK(t, srow); const size_t hk_ = ((size_t)(b * 16 + h) * 2048 + (tk - tokbase)) * 64 + sch * 8; kreg##S = *(const u32x4*)(Kp + hk_); vreg##S = *(const u32x4*)(Vp + hk_); \
        if (DQK == 96 && tid < 256) { const size_t tr = (size_t)ATT_TOK(t, rrow); rreg##S = *(const u32x4*)(KRp + tr * 32 + rch * 8); } } while (0)
#define ATT_STORE(S, buf) do { *(LAS u32x4*)(Kl + (buf) * KBUF + srow * KSTR + sch * 16) = kreg##S; \
        *(LAS u32x4*)(Vl + (buf) * VBUF + srow * 128 + (((sch >> 2) ^ ((srow >> 1) & 1)) * 64) + (sch & 3) * 16) = vreg##S; \
        if (DQK == 96 && tid < 256) *(LAS u32x4*)(Kl + (buf) * KBUF + rrow * KSTR + 128 + rch * 16) = rreg##S; } while (0)
    bf16x8 qf[NKS];
#pragma unroll
    for (int d0 = 0; d0 < NKS; ++d0) qf[d0] = *(const bf16x8*)(Qp + ((size_t)(b * 16 + h) * 2048 + (tq - tokbase)) * DQK + d0 * 16 + hi * 8);
    const bool rev = (mode != 0);
#define ATT_SEQ(i) (rev ? nt - 1 - (i) : (i))
    ATT_LOAD(0, ATT_SEQ(0));
    ATT_LOAD(1, ATT_SEQ(1));
    ATT_STORE(0, 0);
    __syncthreads();
    const float NEG = -1e30f, THR = 8.0f;
    float mrun = 0.f, lrun = 0.f; f32x16 o[2]; o[0] = (f32x16){}; o[1] = (f32x16){};
    bool first = true;
    const int q4 = (lane & 15) >> 2, p4 = lane & 3, g1 = (lane >> 4) & 1;
    const int voff = q4 * 128 + g1 * 32 + p4 * 8 + hi * 4 * 128;
    const int vsw = (q4 >> 1) & 1;
    auto tile_compute = [&](const int t, const int buf) __attribute__((always_inline)) {
        const int bA = rev ? 1 : 0, bB = 1 - bA;
        bool actA, actB, intA, intB; int kbA, kbB;
#define ATT_CLASS(b2, act_, int_, kb_) do { \
            if (mode == 0) { kb_ = 64 * t + 32 * (b2); act_ = kb_ <= qs_w + 31; int_ = kb_ + 31 <= qs_w; } \
            else if (mode == 3) { kb_ = 32 * t; act_ = ((b2) == (w >> 2)) && (32 * t <= qs_w + 31); int_ = kb_ + 31 <= qs_w; } \
            else { kb_ = ks0 + 64 * t + 32 * (b2); act_ = (kb_ <= qs_w + 31) && (kb_ + 31 >= qs_w - 128); int_ = (kb_ + 31 <= qs_w) && (qs_w + 31 - kb_ <= 128); } } while (0)
        ATT_CLASS(bA, actA, intA, kbA); ATT_CLASS(bB, actB, intB, kbB);
#define ATT_INIT(a, kb_, int_) do { const int base_ = (qs_w + r32) - (kb_) - 4 * hi; const float t0_ = -(slope2 * (float)base_ + mrun); \
            if (int_) { _Pragma("unroll") for (int r = 0; r < 16; ++r) a[r] = fmaf(slope2, (float)((r & 3) + 8 * (r >> 2)), t0_); } \
            else { _Pragma("unroll") for (int r = 0; r < 16; ++r) { const int delta_ = base_ - ((r & 3) + 8 * (r >> 2)); a[r] = ((unsigned)delta_ <= (unsigned)maxback) ? fmaf(slope2, (float)((r & 3) + 8 * (r >> 2)), t0_) : NEG; } } } while (0)
#define ATT_KREAD(kf, b2) do { const LAS unsigned char* kp_ = Kl + buf * KBUF + (32 * (b2) + r32) * KSTR + hi * 16; _Pragma("unroll") for (int d0 = 0; d0 < NKS; ++d0) kf[d0] = *(const LAS bf16x8*)(kp_ + d0 * 32); } while (0)
#define ATT_VREAD(vl, vh, b2) do { _Pragma("unroll") for (int s = 0; s < 2; ++s) { const LAS unsigned char* vp_ = Vl + buf * VBUF + voff + (32 * (b2) + 16 * s) * 128; \
            _Pragma("unroll") for (int db = 0; db < 2; ++db) { vl[s][db] = vtr(vp_ + ((db ^ vsw) * 64)); vh[s][db] = vtr(vp_ + 8 * 128 + ((db ^ vsw) * 64)); } } } while (0)
#define ATT_PACK(pf, e) do { _Pragma("unroll") for (int s = 0; s < 2; ++s) { u32x4 pw_; pw_.x = cvtpk(e[8 * s + 0], e[8 * s + 1]); pw_.y = cvtpk(e[8 * s + 2], e[8 * s + 3]); pw_.z = cvtpk(e[8 * s + 4], e[8 * s + 5]); pw_.w = cvtpk(e[8 * s + 6], e[8 * s + 7]); pf[s] = __builtin_bit_cast(bf16x8, pw_); } } while (0)
#define ATT_VF(vl, vh, s, db) (bf16x8){vl[s][db][0], vl[s][db][1], vl[s][db][2], vl[s][db][3], vh[s][db][0], vh[s][db][1], vh[s][db][2], vh[s][db][3]}
#define ATT_SB() __builtin_amdgcn_sched_barrier(0)
#define ATT_EXPS(X, lo, hi_, ls_) do { _Pragma("unroll") for (int r = (lo); r < (hi_); ++r) { const float ev_ = __builtin_amdgcn_exp2f(X[r]); X[r] = ev_; ls_ += ev_; } } while (0)
#define ATT_MAX16(X, m_) do { m_ = NEG; _Pragma("unroll") for (int r = 0; r < 16; ++r) m_ = fmaxf(m_, X[r]); m_ = fmaxf(m_, xhalf(m_)); } while (0)
        if (actA && actB && !first) {
            f32x16 pA, pB; float lsA = 0.f, lsB = 0.f, dlA = 0.f, dlB = 0.f; bool needA = false, needB = false; bf16x8 kfa[NKS], kfb[NKS];
            ATT_KREAD(kfa, bA); ATT_INIT(pA, kbA, intA); ATT_INIT(pB, kbB, intB);
            ATT_SB();
#pragma unroll
            for (int d0 = 0; d0 < NKS; ++d0) pA = __builtin_amdgcn_mfma_f32_32x32x16_bf16(kfa[d0], qf[d0], pA, 0, 0, 0);
            ATT_KREAD(kfb, bB);
            ATT_SB();
            s16x4 vla[2][2], vha[2][2], vlb[2][2], vhb[2][2];
#pragma unroll
            for (int d0 = 0; d0 < NKS; ++d0) {
                pB = __builtin_amdgcn_mfma_f32_32x32x16_bf16(kfb[d0], qf[d0], pB, 0, 0, 0);
                if (d0 == 0) { float mtA; ATT_MAX16(pA, mtA); needA = __any(mtA > THR);
                    if (needA) { dlA = fmaxf(mtA, 0.f); const float alpha = __builtin_amdgcn_exp2f(-dlA); mrun += dlA; lrun *= alpha;
#pragma unroll
                        for (int r = 0; r < 16; ++r) { o[0][r] *= alpha; o[1][r] *= alpha; pA[r] -= dlA; } } }
                else if (NKS == 6) { if (d0 <= 4) ATT_EXPS(pA, 4 * (d0 - 1), 4 * d0, lsA); }
                else { if (d0 == 1) ATT_EXPS(pA, 0, 6, lsA); else if (d0 == 2) ATT_EXPS(pA, 6, 11, lsA); else ATT_EXPS(pA, 11, 16, lsA); }
                if (d0 == NKS - 1) ATT_VREAD(vla, vha, bA);
                ATT_SB();
            }
            bf16x8 pfA[2], pfB[2];
            ATT_PACK(pfA, pA);
            ATT_SB();
#pragma unroll
            for (int s = 0; s < 2; ++s)
#pragma unroll
                for (int db = 0; db < 2; ++db) {
                    o[db] = __builtin_amdgcn_mfma_f32_32x32x16_bf16(ATT_VF(vla, vha, s, db), pfA[s], o[db], 0, 0, 0);
                    const int g = 2 * s + db;
                    if (g == 0) { if (needA) {
#pragma unroll
                            for (int r = 0; r < 16; ++r) pB[r] -= dlA; }
                        float mtB; ATT_MAX16(pB, mtB); needB = __any(mtB > THR);
                        if (needB) { dlB = fmaxf(mtB, 0.f);
#pragma unroll
                            for (int r = 0; r < 16; ++r) pB[r] -= dlB; } }
                    else if (g == 1) ATT_EXPS(pB, 0, 6, lsB); else if (g == 2) ATT_EXPS(pB, 6, 11, lsB); else ATT_EXPS(pB, 11, 16, lsB);
                    if (g == 3) ATT_VREAD(vlb, vhb, bB);
                    ATT_SB();
                }
            ATT_PACK(pfB, pB);
            if (needB) { const float alpha = __builtin_amdgcn_exp2f(-dlB); mrun += dlB; lrun = (lrun + lsA) * alpha;
#pragma unroll
                for (int r = 0; r < 16; ++r) { o[0][r] *= alpha; o[1][r] *= alpha; } }
            else lrun += lsA;
#pragma unroll
            for (int s = 0; s < 2; ++s)
#pragma unroll
                for (int db = 0; db < 2; ++db) o[db] = __builtin_amdgcn_mfma_f32_32x32x16_bf16(ATT_VF(vlb, vhb, s, db), pfB[s], o[db], 0, 0, 0);
            lrun += lsB;
        } else if (actA || actB) {
#pragma unroll
            for (int k2 = 0; k2 < 2; ++k2) if (k2 == 0 ? actA : actB) {
                const int b2 = k2 == 0 ? bA : bB; const int kbx = k2 == 0 ? kbA : kbB; const bool intx = k2 == 0 ? intA : intB;
                f32x16 a; bf16x8 kf[NKS]; s16x4 vl[2][2], vh[2][2];
                ATT_KREAD(kf, b2); ATT_INIT(a, kbx, intx);
#pragma unroll
                for (int d0 = 0; d0 < NKS; ++d0) a = __builtin_amdgcn_mfma_f32_32x32x16_bf16(kf[d0], qf[d0], a, 0, 0, 0);
                ATT_VREAD(vl, vh, b2);
                float mt; ATT_MAX16(a, mt);
                if (first || __any(mt > 0.f)) {
                    const float dl = first ? mt : fmaxf(mt, 0.f);
                    const float alpha = first ? 1.0f : __builtin_amdgcn_exp2f(-dl); mrun += dl; lrun *= alpha;
#pragma unroll
                    for (int r = 0; r < 16; ++r) { o[0][r] *= alpha; o[1][r] *= alpha; a[r] -= dl; }
                    first = false;
                }
                float ls = 0.f;
                ATT_EXPS(a, 0, 16, ls);
                lrun += ls;
                bf16x8 pf[2]; ATT_PACK(pf, a);
#pragma unroll
                for (int s = 0; s < 2; ++s)
#pragma unroll
                    for (int db = 0; db < 2; ++db) o[db] = __builtin_amdgcn_mfma_f32_32x32x16_bf16(ATT_VF(vl, vh, s, db), pf[s], o[db], 0, 0, 0);
            }
        }
    };
    for (int it = 0; it < nt; it += 2) {
        if (it + 2 < nt) ATT_LOAD(0, ATT_SEQ(it + 2));
        tile_compute(ATT_SEQ(it), 0);
        ATT_STORE(1, 1);
        __syncthreads();
        if (it + 3 < nt) ATT_LOAD(1, ATT_SEQ(it + 3));
        tile_compute(ATT_SEQ(it + 1), 1);
        if (it + 2 < nt) ATT_STORE(0, 0);
        __syncthreads();
    }
    const float ltot = lrun + xhalf(lrun); const float inv = 1.0f / ltot;
    store_o_rows<false>(lds + LDS_OST + w * OST_WAVE, o, inv, Op + h * 64, tokbase + qs_w * d + res_w, d, lane);
    if (lsep && hi == 0) lsep[(size_t)tq * 16 + h] = mrun + log2f(ltot);
#undef ATT_TOK
#undef ATT_SEQ
#undef ATT_CLASS
#undef ATT_EXPS
#undef ATT_MAX16
#undef ATT_INIT
#undef ATT_KREAD
#undef ATT_VREAD
#undef ATT_PACK
#undef ATT_VF
#undef ATT_SB
#undef ATT_LOAD
#undef ATT_STORE
}

__device__ __forceinline__ void dil_phase(LAS unsigned char* lds, int bhbase, int member, const bf16* Qp, const bf16* Kp, const bf16* Vp, bf16* Opart, size_t ostride, float* lse) {
    constexpr int KSTR = 144, KBYTES = 384 * KSTR, NKS = 4;
    const int tid = pg8::pg8_ltid(), lane = tid & 63, r32 = lane & 31, hi = lane >> 5; const int w = __builtin_amdgcn_readfirstlane(tid >> 6);
    LAS unsigned char* Kl = lds; LAS unsigned char* Vl = lds + KBYTES;
    const int srow = tid >> 3, sch = tid & 7;
    const int q4 = (lane & 15) >> 2, p4 = lane & 3, g1 = (lane >> 4) & 1;
    const int voff = q4 * 128 + g1 * 32 + p4 * 8 + hi * 4 * 128, vsw = (q4 >> 1) & 1;
    const float NEG = -1e30f;
    u32x4 kr[6], vr[6]; bf16x8 qn[NKS];
#define DIL_GEOM(k) const int st_ = (k) / 3, mode = 1 + (k) % 3, blk = (member + st_) & 7, bh = bhbase + st_; const int b = bh >> 4, h = bh & 15, tokbase = b * SEQ; int d, res, qs0, ks0, nrows; \
        if (mode == 1) { d = 1; res = 0; qs0 = 256 * blk; ks0 = qs0 >= 128 ? qs0 - 128 : 0; nrows = qs0 + 256 - ks0; } \
        else if (mode == 2) { d = 4; res = blk >> 1; qs0 = 256 * (blk & 1); ks0 = qs0 >= 128 ? qs0 - 128 : 0; nrows = qs0 + 256 - ks0; } \
        else { d = 16; res = 0; qs0 = 0; ks0 = 0; nrows = 256; } \
        const int qs_w = mode == 3 ? 32 * (w & 3) : qs0 + 32 * w, res_w = mode == 3 ? 2 * blk + (w >> 2) : res; \
        const int tq = tokbase + (qs_w + r32) * d + res_w;
#define DIL_FETCH(k) do { DIL_GEOM(k) (void)qs_w; \
        _Pragma("unroll") for (int jj = 0; jj < 6; ++jj) if (64 * jj < nrows) { const int row = srow + 64 * jj; \
            const size_t tk = (size_t)(mode == 3 ? tokbase + (row & 127) * 16 + 2 * blk + (row >> 7) : tokbase + (ks0 + row) * d + res); \
            const size_t hk_ = ((size_t)bh * 2048 + (tk - tokbase)) * 64 + sch * 8; kr[jj] = *(const u32x4*)(Kp + hk_); vr[jj] = *(const u32x4*)(Vp + hk_); } \
        _Pragma("unroll") for (int d0 = 0; d0 < NKS; ++d0) qn[d0] = *(const bf16x8*)(Qp + ((size_t)bh * 2048 + (tq - tokbase)) * 64 + d0 * 16 + hi * 8); } while (0)
    DIL_FETCH(0);
    for (int u = 0; u < 24; ++u) {
        DIL_GEOM(u)
#pragma unroll
        for (int jj = 0; jj < 6; ++jj) if (64 * jj < nrows) { const int row = srow + 64 * jj;
            *(LAS u32x4*)(Kl + row * KSTR + sch * 16) = kr[jj];
            *(LAS u32x4*)(Vl + row * 128 + (((sch >> 2) ^ ((row >> 1) & 1)) * 64) + (sch & 3) * 16) = vr[jj]; }
        bf16x8 qf[NKS];
#pragma unroll
        for (int d0 = 0; d0 < NKS; ++d0) qf[d0] = qn[d0];
        __syncthreads();
        if (u + 1 < 24) DIL_FETCH(u + 1);
        const float slope2 = exp2f(-0.5f * (float)(h + 1)) * LOG2E * (float)d;
        const int kbi0 = mode == 3 ? (w & 3) : (qs_w - ks0) >> 5;
        const int nblk = kbi0 + 1 < 5 ? kbi0 + 1 : 5;
        const int rowoff = mode == 3 ? 128 * (w >> 2) : 0;
        float mrun = 0.f, lrun = 0.f; f32x16 o[2]; o[0] = (f32x16){}; o[1] = (f32x16){};
        for (int i = 0; i < nblk; i += 2) {
            const bool hasB = i + 1 < nblk;
            const int kbiA = kbi0 - i, kbiB = hasB ? kbiA - 1 : kbiA;
            const int rbA = rowoff + 32 * kbiA, kbA = ks0 + 32 * kbiA, rbB = rowoff + 32 * kbiB, kbB = ks0 + 32 * kbiB;
            bf16x8 kfA[NKS], kfB[NKS];
            { const LAS unsigned char* kp = Kl + (rbA + r32) * KSTR + hi * 16;
#pragma unroll
              for (int d0 = 0; d0 < NKS; ++d0) kfA[d0] = *(const LAS bf16x8*)(kp + d0 * 32); }
            { const LAS unsigned char* kp = Kl + (rbB + r32) * KSTR + hi * 16;
#pragma unroll
              for (int d0 = 0; d0 < NKS; ++d0) kfB[d0] = *(const LAS bf16x8*)(kp + d0 * 32); }
            f32x16 aA, aB;
#define DIL_INIT(a, kb_) do { const bool inter_ = ((kb_) + 31 <= qs_w) && (qs_w + 31 - (kb_) <= 128); const int base_ = (qs_w + r32) - (kb_) - 4 * hi; const float t0_ = -(slope2 * (float)base_ + mrun); \
              if (inter_) { _Pragma("unroll") for (int r = 0; r < 16; ++r) a[r] = fmaf(slope2, (float)((r & 3) + 8 * (r >> 2)), t0_); } \
              else { _Pragma("unroll") for (int r = 0; r < 16; ++r) { const int delta_ = base_ - ((r & 3) + 8 * (r >> 2)); a[r] = ((unsigned)delta_ <= 128u) ? fmaf(slope2, (float)((r & 3) + 8 * (r >> 2)), t0_) : NEG; } } } while (0)
            DIL_INIT(aA, kbA);
            if (hasB) DIL_INIT(aB, kbB); else {
#pragma unroll
                for (int r = 0; r < 16; ++r) aB[r] = NEG; }
#pragma unroll
            for (int d0 = 0; d0 < NKS; ++d0) {
                aA = __builtin_amdgcn_mfma_f32_32x32x16_bf16(kfA[d0], qf[d0], aA, 0, 0, 0);
                if (hasB) aB = __builtin_amdgcn_mfma_f32_32x32x16_bf16(kfB[d0], qf[d0], aB, 0, 0, 0); }
            s16x4 vlA[2][2], vhA[2][2], vlB[2][2], vhB[2][2];
#pragma unroll
            for (int s = 0; s < 2; ++s) { const LAS unsigned char* vpA = Vl + voff + (rbA + 16 * s) * 128; const LAS unsigned char* vpB = Vl + voff + (rbB + 16 * s) * 128;
#pragma unroll
                for (int db = 0; db < 2; ++db) { vlA[s][db] = vtr(vpA + ((db ^ vsw) * 64)); vhA[s][db] = vtr(vpA + 8 * 128 + ((db ^ vsw) * 64));
                                                 vlB[s][db] = vtr(vpB + ((db ^ vsw) * 64)); vhB[s][db] = vtr(vpB + 8 * 128 + ((db ^ vsw) * 64)); } }
            float mt = NEG;
#pragma unroll
            for (int r = 0; r < 16; ++r) mt = fmaxf(mt, fmaxf(aA[r], aB[r]));
            mt = fmaxf(mt, xhalf(mt));
            if (i == 0 || __any(mt > 0.f)) {
                const float dl = i == 0 ? mt : fmaxf(mt, 0.f);
                const float alpha = i == 0 ? 1.0f : __builtin_amdgcn_exp2f(-dl); mrun += dl; lrun *= alpha;
#pragma unroll
                for (int r = 0; r < 16; ++r) { o[0][r] *= alpha; o[1][r] *= alpha; aA[r] -= dl; aB[r] -= dl; }
            }
            float ls = 0.f;
#pragma unroll
            for (int r = 0; r < 16; ++r) { aA[r] = __builtin_amdgcn_exp2f(aA[r]); ls += aA[r]; }
            if (hasB) {
#pragma unroll
                for (int r = 0; r < 16; ++r) { aB[r] = __builtin_amdgcn_exp2f(aB[r]); ls += aB[r]; } }
            lrun += ls;
#pragma unroll
            for (int s = 0; s < 2; ++s) {
                u32x4 pw; pw.x = cvtpk(aA[8 * s + 0], aA[8 * s + 1]); pw.y = cvtpk(aA[8 * s + 2], aA[8 * s + 3]); pw.z = cvtpk(aA[8 * s + 4], aA[8 * s + 5]); pw.w = cvtpk(aA[8 * s + 6], aA[8 * s + 7]);
                const bf16x8 pf = __builtin_bit_cast(bf16x8, pw);
#pragma unroll
                for (int db = 0; db < 2; ++db) {
                    const bf16x8 vf = (bf16x8){vlA[s][db][0], vlA[s][db][1], vlA[s][db][2], vlA[s][db][3], vhA[s][db][0], vhA[s][db][1], vhA[s][db][2], vhA[s][db][3]};
                    o[db] = __builtin_amdgcn_mfma_f32_32x32x16_bf16(vf, pf, o[db], 0, 0, 0); }
            }
            if (hasB) {
#pragma unroll
                for (int s = 0; s < 2; ++s) {
                    u32x4 pw; pw.x = cvtpk(aB[8 * s + 0], aB[8 * s + 1]); pw.y = cvtpk(aB[8 * s + 2], aB[8 * s + 3]); pw.z = cvtpk(aB[8 * s + 4], aB[8 * s + 5]); pw.w = cvtpk(aB[8 * s + 6], aB[8 * s + 7]);
                    const bf16x8 pf = __builtin_bit_cast(bf16x8, pw);
#pragma unroll
                    for (int db = 0; db < 2; ++db) {
                        const bf16x8 vf = (bf16x8){vlB[s][db][0], vlB[s][db][1], vlB[s][db][2], vlB[s][db][3], vhB[s][db][0], vhB[s][db][1], vhB[s][db][2], vhB[s][db][3]};
                        o[db] = __builtin_amdgcn_mfma_f32_32x32x16_bf16(vf, pf, o[db], 0, 0, 0); }
                } }
        }
#undef DIL_INIT
        const float ltot = lrun + xhalf(lrun); const float inv = 1.0f / ltot;
        store_o_rows<true>(lds + LDS_OST + w * OST_WAVE, o, inv, Opart + (size_t)(mode - 1) * ostride + h * 64, tokbase + qs_w * d + res_w, d, lane);
        if (hi == 0) lse[(size_t)(mode - 1) * M * 16 + (size_t)tq * 16 + h] = mrun + log2f(ltot);
        __syncthreads();
    }
#undef DIL_GEOM
#undef DIL_FETCH
}

struct Args { const float* in[20]; float* out; unsigned char* ws; };

typedef const __attribute__((address_space(4))) Args* KArgsP;
__device__ __forceinline__ KArgsP kargs() { KArgsP p = (KArgsP)__builtin_amdgcn_kernarg_segment_ptr(); asm volatile("" : "+s"(p)); return p; }
#define WSP(T, off) ((T*)(pa->ws + (off)))

__global__ void __launch_bounds__(NTHREADS, 2) yoco_fwd(Args args_unused) {
    extern __shared__ __attribute__((aligned(16))) unsigned char lds_raw[];
    LAS unsigned char* lds = (LAS unsigned char*)lds_raw;
    cg::grid_group grid = cg::this_grid();
#define PHASE_IDS const int tid = pg8::pg8_ltid(), lane = tid & 63; const int wave = __builtin_amdgcn_readfirstlane(tid >> 6); int bid = blockIdx.x; asm volatile("" : "+s"(bid)); \
    const int G = gridDim.x; const int gw = bid * NWAVES + wave, ngw = G * NWAVES; const int gtid = bid * NTHREADS + tid, gthreads = G * NTHREADS; (void)lane; (void)gw; (void)ngw; (void)gtid; (void)gthreads;

    if (threadIdx.x < 2) ((LAS unsigned*)(lds + LDS_MISC))[threadIdx.x] = 0u;
    __syncthreads();
    {
        KArgsP pa = kargs(); PHASE_IDS
        LAS float* scr = (LAS float*)(lds + wave * 16384);
        constexpr int I0 = 16 * 96, I1 = 16 * 32, I2 = 16 * 24, I3 = 4 * 64, I4 = 6 * 48, I5 = 16 * 32, I6 = 16 * 176, I7 = 44 * 32;
        constexpr int NIT = I0 + I1 + I2 + I3 + I4 + I5 + 2 * I6 + 2 * I7;
        for (int it = gw; it < NIT; it += ngw) {
            int r = it;
            if (r < I0) { prep_item<0>(PrepSrc{pa->in[1], nullptr, nullptr, nullptr}, 1024, 3072, WSP(bf16, WS_WQKV), scr, r, lane); continue; } r -= I0;
            if (r < I1) { prep_item<0>(PrepSrc{pa->in[2], nullptr, nullptr, nullptr}, 1024, 1024, WSP(bf16, WS_WOA), scr, r, lane); continue; } r -= I1;
            if (r < I2) { prep_item<1>(PrepSrc{pa->in[3], pa->in[8], pa->in[5], nullptr}, 1024, 768, WSP(bf16, WS_WLAT), scr, r, lane); continue; } r -= I2;
            if (r < I3) { prep_item<2>(PrepSrc{pa->in[6], pa->in[7], nullptr, pa->in[4]}, 256, 2048, WSP(bf16, WS_WUKV), scr, r, lane); continue; } r -= I3;
            if (r < I4) { prep_item<3>(PrepSrc{pa->in[10], nullptr, nullptr, pa->in[9]}, 384, 1536, WSP(bf16, WS_WUQ), scr, r, lane); continue; } r -= I4;
            if (r < I5) { prep_item<0>(PrepSrc{pa->in[11], nullptr, nullptr, nullptr}, 1024, 1024, WSP(bf16, WS_WOB), scr, r, lane); continue; } r -= I5;
            if (r < I6) { prep_item<4>(PrepSrc{pa->in[12], nullptr, nullptr, nullptr}, 1024, 5632, WSP(bf16, WS_WIN0), scr, r, lane); continue; } r -= I6;
            if (r < I6) { prep_item<4>(PrepSrc{pa->in[12] + (size_t)1024 * 5632, nullptr, nullptr, nullptr}, 1024, 5632, WSP(bf16, WS_WIN1), scr, r, lane); continue; } r -= I6;
            if (r < I7) { prep_item<0>(PrepSrc{pa->in[15], nullptr, nullptr, nullptr}, 2816, 1024, WSP(bf16, WS_WOUT0), scr, r, lane); continue; } r -= I7;
            prep_item<0>(PrepSrc{pa->in[15] + (size_t)2816 * 1024, nullptr, nullptr, nullptr}, 2816, 1024, WSP(bf16, WS_WOUT1), scr, r, lane);
        }
        float* rope = WSP(float, WS_ROPE);
        for (int i = gtid; i < SEQ * 16; i += gthreads) {
            const int t = i >> 4, k = i & 15; double f = 1.0; for (int j = 0; j < k; ++j) f *= 0.5623413251903491;
            const float inv_freq = (float)f; const float ang = (float)t * inv_freq;
            const double rev = (double)ang * 0.15915494309189535; const double fr = rev - __builtin_rint(rev);
            rope[2 * i] = __builtin_amdgcn_cosf((float)fr); rope[2 * i + 1] = __builtin_amdgcn_sinf((float)fr);
        }
        if (bid == 0) { unsigned* bw = WSP(unsigned, WS_BAR); for (int i = tid; i < XCD_BAR_WORDS; i += NTHREADS) bw[i] = 0u; }
        { float* rs0 = WSP(float, WS_RS); for (int i = gtid; i < M * 2; i += gthreads) rs0[i] = 0.f; }
        const float* x_in = pa->in[0]; bf16* XB = WSP(bf16, WS_XB);
        for (size_t i = gtid; i < (size_t)M * D / 8; i += gthreads) {
            const f32x4 a = __builtin_nontemporal_load((const f32x4*)x_in + 2 * i), c = __builtin_nontemporal_load((const f32x4*)x_in + 2 * i + 1);
            u32x4 o; o.x = pk2(a[0], a[1]); o.y = pk2(a[2], a[3]); o.z = pk2(c[0], c[1]); o.w = pk2(c[2], c[3]); ((u32x4*)XB)[i] = o; }
    }
    grid.sync();
    (void)xcd_barrier_post((unsigned*)(kargs()->ws + WS_BAR), (volatile LAS unsigned*)(lds + LDS_MISC));

    for (int layer = 0; layer < 2; ++layer) {
        if (layer == 0) {
            { KArgsP pa = kargs(); PHASE_IDS
              pg8::Gemm g{WSP(bf16, WS_XB), WSP(bf16, WS_WQKV), M, 3072, 1024, 1024, 1024}; pg8::StaticOrder S; S.init(M, 3072, G, bid);
              pg8::EpiQKV E{WSP(bf16, WS_R1), (size_t)(WS_R2 - WS_R1) / 2, 0.125f * LOG2E};
              pg8::gemm_phase<pg8::EpiQKV, pg8::StaticOrder, true, true>(lds, g, S, E); }
            GRID_BAR();
            { KArgsP pa = kargs(); PHASE_IDS
              for (int grp = bid; grp < BATCH * NH; grp += G) { const int x = grp & 7, i = grp >> 3;
                  dil_phase(lds, x * 32 + (i >> 3) * 8, i & 7, WSP(bf16, WS_R1), WSP(bf16, WS_R2), WSP(bf16, WS_R3), WSP(bf16, WS_R4), (size_t)(WS_R5 - WS_R4) / 2, WSP(float, WS_LSE)); } }
            GRID_BAR();
            { KArgsP pa = kargs(); PHASE_IDS
              const float* LSE = WSP(float, WS_LSE); const bf16 *R4 = WSP(bf16, WS_R4), *R5 = WSP(bf16, WS_R5), *R6 = WSP(bf16, WS_R6); bf16* R1 = WSP(bf16, WS_R1);
              for (size_t it = gtid; it < (size_t)M * 128; it += gthreads) {
                const size_t tok = it >> 7; const int c8 = (int)(it & 127), hh = c8 >> 3;
                const float l0 = LSE[tok * 16 + hh], l1 = LSE[(size_t)M * 16 + tok * 16 + hh], l2 = LSE[(size_t)2 * M * 16 + tok * 16 + hh];
                const float mx = fmaxf(l0, fmaxf(l1, l2)); float w0 = exp2f(l0 - mx), w1 = exp2f(l1 - mx), w2 = exp2f(l2 - mx); const float inv = 1.0f / (w0 + w1 + w2); w0 *= inv; w1 *= inv; w2 *= inv;
                const u32x4 a = __builtin_nontemporal_load((const u32x4*)(R4 + tok * 1024 + c8 * 8)), bq = __builtin_nontemporal_load((const u32x4*)(R5 + tok * 1024 + c8 * 8)), c = __builtin_nontemporal_load((const u32x4*)(R6 + tok * 1024 + c8 * 8));
                u32x4 o;
                o.x = pk2(w0 * bf_lo(a.x) + w1 * bf_lo(bq.x) + w2 * bf_lo(c.x), w0 * bf_hi(a.x) + w1 * bf_hi(bq.x) + w2 * bf_hi(c.x));
                o.y = pk2(w0 * bf_lo(a.y) + w1 * bf_lo(bq.y) + w2 * bf_lo(c.y), w0 * bf_hi(a.y) + w1 * bf_hi(bq.y) + w2 * bf_hi(c.y));
                o.z = pk2(w0 * bf_lo(a.z) + w1 * bf_lo(bq.z) + w2 * bf_lo(c.z), w0 * bf_hi(a.z) + w1 * bf_hi(bq.z) + w2 * bf_hi(c.z));
                o.w = pk2(w0 * bf_lo(a.w) + w1 * bf_lo(bq.w) + w2 * bf_lo(c.w), w0 * bf_hi(a.w) + w1 * bf_hi(bq.w) + w2 * bf_hi(c.w));
                *(u32x4*)(R1 + tok * 1024 + c8 * 8) = o;
              } }
            GRID_BAR();
        } else {
            { KArgsP pa = kargs(); PHASE_IDS
              pg8::Gemm g{WSP(bf16, WS_XB), WSP(bf16, WS_WLAT), M, NLAT, 1024, 1024, 1024}; pg8::StaticOrder S; S.init(M, NLAT, G, bid);
              pg8::EpiLat E{WSP(bf16, WS_R1), WSP(float, WS_RS), WSP(float, WS_ROPE), WSP(bf16, WS_KR)};
              pg8::gemm_phase<pg8::EpiLat, pg8::StaticOrder, true, true>(lds, g, S, E); }
            GRID_BAR();
            { KArgsP pa = kargs(); PHASE_IDS
              pg8::Gemm g{WSP(bf16, WS_R1), WSP(bf16, WS_WUKV), M, 2048, KVR, NLAT, KVR}; pg8::StaticOrder S; S.init(M, 2048, G, bid);
              pg8::EpiMla E{WSP(bf16, WS_R2), 64, 1024, (size_t)(WS_R3 - WS_R2) / 2, WSP(float, WS_RS), 0, 1.f, WSP(float, WS_ROPE), 0, 1.f / KVR};
              pg8::gemm_phase<pg8::EpiMla, pg8::StaticOrder, true, true>(lds, g, S, E); }
            { KArgsP pa = kargs(); PHASE_IDS
              pg8::Gemm g{WSP(bf16, WS_R1) + 256, WSP(bf16, WS_WUQ), M, NQ, QR, NLAT, QR}; pg8::StaticOrder S; S.init(M, NQ, G, bid);
              pg8::EpiMla E{WSP(bf16, WS_R4), 96, 0, 0, WSP(float, WS_RS), 1, 0.10206207261596577f * LOG2E, WSP(float, WS_ROPE), 1, 1.f / QR};
              pg8::gemm_phase<pg8::EpiMla, pg8::StaticOrder, true, true>(lds, g, S, E); }
            GRID_BAR();
            { KArgsP pa = kargs(); PHASE_IDS
              for (int grp = bid; grp < BATCH * NH; grp += G) { const int x = grp & 7, i = grp >> 3, bhbase = x * 32 + (i >> 2) * 4, mem = i & 3;
                for (int st = 0; st < 4; ++st) { const int bh = bhbase + st;
                  for (int half = 0; half < 2; ++half) { const int qb = half == 0 ? 7 - mem : mem;
                    attn_unit<96>(lds, 0, bh >> 4, bh & 15, qb, WSP(bf16, WS_R4), NQ, (bh & 15) * 96, WSP(bf16, WS_R2), WSP(bf16, WS_KR), WSP(bf16, WS_R3), WSP(bf16, WS_R1), nullptr); } } } }
            GRID_BAR();
        }
        { KArgsP pa = kargs(); PHASE_IDS
          pg8::Gemm g{WSP(bf16, WS_R1), layer == 0 ? WSP(bf16, WS_WOA) : WSP(bf16, WS_WOB), M, 1024, 1024, 1024, 1024}; pg8::StaticOrder S; S.init(M, 1024, G, bid);
          pg8::EpiBf16<0> E{WSP(bf16, WS_R2), 1024, nullptr, 0, 0, 1.f};
          pg8::gemm_phase<pg8::EpiBf16<0>, pg8::StaticOrder, true, true>(lds, g, S, E); }
        GRID_BAR();
        { KArgsP pa = kargs(); PHASE_IDS
          ln_rows(layer == 0 ? pa->in[0] : (const float*)nullptr, WSP(bf16, WS_XB), WSP(bf16, WS_R2), pa->in[16] + layer * D, pa->in[17] + layer * D, (float*)nullptr, WSP(bf16, WS_XB), gw, ngw, lane); }
        GRID_BAR();
        { KArgsP pa = kargs(); PHASE_IDS
          pg8::Gemm g{WSP(bf16, WS_XB), layer == 0 ? WSP(bf16, WS_WIN0) : WSP(bf16, WS_WIN1), M, DFF2, 1024, 1024, 1024}; pg8::StaticOrder S; S.init(M, DFF2, G, bid);
          pg8::EpiFfn1 E{WSP(bf16, WS_R1), WSP(bf16, WS_R4), pa->in[13] + (size_t)layer * 3 * DFF2, pa->in[14] + (size_t)layer * DFF2};
          pg8::gemm_phase<pg8::EpiFfn1, pg8::StaticOrder, true, true>(lds, g, S, E); }
        GRID_BAR();
        {
            KArgsP pa = kargs(); PHASE_IDS
            const float* cw = pa->in[13] + (size_t)layer * 3 * DFF2; const float* cb = pa->in[14] + (size_t)layer * DFF2; const bf16* UE = WSP(bf16, WS_R4); bf16* R1 = WSP(bf16, WS_R1);
            for (int it = gtid; it < 512 * 2 * 352; it += gthreads) {
                const int ch = it % 352, rr = (it / 352) & 1, blk = it / 704, f = ch * 8; const bool first = (blk & 31) == 0;
                float cc[2][8];
#pragma unroll
                for (int bj = 0; bj < 2; ++bj) {
                    const u32x4 z = (u32x4){0u, 0u, 0u, 0u};
                    const u32x4 u0 = *(const u32x4*)(UE + ((size_t)(blk * 4 + rr) * 2 + bj) * 2816 + f);
                    const u32x4 u1 = rr == 1 ? *(const u32x4*)(UE + ((size_t)(blk * 4 + 0) * 2 + bj) * 2816 + f) : (first ? z : *(const u32x4*)(UE + ((size_t)((blk - 1) * 4 + 3) * 2 + bj) * 2816 + f));
                    const u32x4 u2 = first ? z : *(const u32x4*)(UE + ((size_t)((blk - 1) * 4 + (rr == 1 ? 3 : 2)) * 2 + bj) * 2816 + f);
                    const float* w0 = cw + bj * 2816 + f; const float* w1 = w0 + 5632; const float* w2 = w1 + 5632; const float* bb = cb + bj * 2816 + f;
#pragma unroll
                    for (int e = 0; e < 4; ++e) {
                        cc[bj][2 * e] = bb[2 * e] + w2[2 * e] * bf_lo(u0[e]) + w1[2 * e] * bf_lo(u1[e]) + w0[2 * e] * bf_lo(u2[e]);
                        cc[bj][2 * e + 1] = bb[2 * e + 1] + w2[2 * e + 1] * bf_hi(u0[e]) + w1[2 * e + 1] * bf_hi(u1[e]) + w0[2 * e + 1] * bf_hi(u2[e]); }
                }
                u32x4 o; o.x = pk2(silu_mul(cc[0][0], cc[1][0]), silu_mul(cc[0][1], cc[1][1])); o.y = pk2(silu_mul(cc[0][2], cc[1][2]), silu_mul(cc[0][3], cc[1][3]));
                o.z = pk2(silu_mul(cc[0][4], cc[1][4]), silu_mul(cc[0][5], cc[1][5])); o.w = pk2(silu_mul(cc[0][6], cc[1][6]), silu_mul(cc[0][7], cc[1][7]));
                *(u32x4*)(R1 + (size_t)(64 * blk + rr) * 2816 + f) = o;
            }
        }
        GRID_BAR();
        { KArgsP pa = kargs(); PHASE_IDS
          pg8::Gemm g{WSP(bf16, WS_R1), layer == 0 ? WSP(bf16, WS_WOUT0) : WSP(bf16, WS_WOUT1), M, 1024, DFF, DFF, DFF}; pg8::StaticOrder S; S.init(M, 1024, G, bid);
          pg8::EpiBf16<0> E{WSP(bf16, WS_R5), 1024, nullptr, 0, 0, 1.f};
          pg8::gemm_phase<pg8::EpiBf16<0>, pg8::StaticOrder, true, true>(lds, g, S, E); }
        GRID_BAR();
        { KArgsP pa = kargs(); PHASE_IDS
          ln_rows((const float*)nullptr, WSP(bf16, WS_XB), WSP(bf16, WS_R5), pa->in[18] + layer * D, pa->in[19] + layer * D, layer == 0 ? (float*)nullptr : pa->out, layer == 0 ? WSP(bf16, WS_XB) : (bf16*)nullptr, gw, ngw, lane); }
        if (layer == 0) GRID_BAR();
    }
}

extern "C" void kernel_launch(void* const* d_in, const int* in_sizes, int n_in, void* d_out, int out_size, void* d_ws, size_t ws_size, hipStream_t stream) {
    static int grid = 0;
    if (grid == 0) {
        if (n_in != 20 || in_sizes[0] != M * D || out_size != M * D || ws_size < WS_END) { fprintf(stderr, "kernel_launch: unexpected shapes (n_in %d, in0 %d, out %d, ws %zu); nothing launched\n", n_in, n_in > 0 ? in_sizes[0] : -1, out_size, ws_size); grid = -1; return; }
        int dev = 0, cus = 0, per_cu = 0;
        if (hipGetDevice(&dev) != hipSuccess || hipDeviceGetAttribute(&cus, hipDeviceAttributeMultiprocessorCount, dev) != hipSuccess) { fprintf(stderr, "kernel_launch: device query failed\n"); grid = -1; return; }
        if (hipFuncSetAttribute((const void*)yoco_fwd, hipFuncAttributeMaxDynamicSharedMemorySize, LDS_BYTES) != hipSuccess) { fprintf(stderr, "kernel_launch: hipFuncSetAttribute failed\n"); grid = -1; return; }
        if (hipOccupancyMaxActiveBlocksPerMultiprocessor(&per_cu, (const void*)yoco_fwd, NTHREADS, LDS_BYTES) != hipSuccess || per_cu < 1) { fprintf(stderr, "kernel_launch: occupancy query says %d blocks per CU\n", per_cu); (void)hipGetLastError(); per_cu = 1; }
        grid = cus * 1;
    }
    if (grid < 0) return;
    Args a{};
    for (int i = 0; i < 20; ++i) a.in[i] = (const float*)d_in[i];
    a.out = (float*)d_out; a.ws = (unsigned char*)d_ws;
    void* kargs[] = {&a};
    const hipError_t e = hipLaunchCooperativeKernel((const void*)yoco_fwd, dim3(grid), dim3(NTHREADS), kargs, LDS_BYTES, stream);
    if (e != hipSuccess) fprintf(stderr, "kernel_launch: cooperative launch failed: %s (grid %d)\n", hipGetErrorString(e), grid);
}
```
